# Optimizing an MI355X kernel written in HIP

```python
import math
import jax, jax.numpy as jnp
from jax import lax
import numpy as np

D_MODEL = 1024
BATCH = 16
SEQ = 2048
DEPTH = 1

MIX_WIDTH = D_MODEL
ATTN_WIDTH = MIX_WIDTH // 2
POOL_WIDTH = MIX_WIDTH - ATTN_WIDTH
N_DIFF_HEADS = 4
DIFF_HEAD_DIM = ATTN_WIDTH // (2 * N_DIFF_HEADS)
DIFF_VALUE_DIM = 2 * DIFF_HEAD_DIM
ROT_DIM = DIFF_HEAD_DIM // 4
ROPE_THETA = 500000.0
Q_BLOCK = 128
POOL_WINDOWS = (2, 4, 8, 16)
N_POOL_GROUPS = len(POOL_WINDOWS)
POOL_GROUP_DIM = POOL_WIDTH // N_POOL_GROUPS
IN_COLS = 3 * ATTN_WIDTH + POOL_WIDTH
N_EXPERT_GROUPS = 4
EXPERTS_PER_GROUP = 8
N_EXPERTS = N_EXPERT_GROUPS * EXPERTS_PER_GROUP
TOP_K_IN_GROUP = 2
D_EXPERT = D_MODEL // 2
MOE_BLOCK = 128
RMS_EPS = 1e-6
N_MOD = 6

kernel_name = "hybrid_diffattn_pool_hmoe_encoder"


def rms_norm(x, g):
    xf = x.astype(jnp.float32)
    y = xf * lax.rsqrt(jnp.mean(xf * xf, axis=-1, keepdims=True) + RMS_EPS)
    return (y * g.astype(jnp.float32)).astype(x.dtype)


def lambda_init_for(layer_idx):
    return 0.8 - 0.6 * math.exp(-0.3 * layer_idx)


def rope_tables(seq_len):
    pos = jnp.arange(seq_len, dtype=jnp.float32)
    inv_freq = ROPE_THETA ** (-jnp.arange(0, ROT_DIM, 2, dtype=jnp.float32) / ROT_DIM)
    ang = pos[:, None] * inv_freq[None, :]
    return jnp.cos(ang), jnp.sin(ang)


def apply_partial_rope(t, cos, sin):
    half = ROT_DIM // 2
    cs = cos[None, :, None, None, :].astype(t.dtype)
    sn = sin[None, :, None, None, :].astype(t.dtype)
    t1 = t[..., :half]
    t2 = t[..., half:ROT_DIM]
    return jnp.concatenate([t1 * cs - t2 * sn, t2 * cs + t1 * sn, t[..., ROT_DIM:]], axis=-1)


def diff_attention(q, k, v, lam, subln_g, lambda_init):
    B, S = q.shape[0], q.shape[1]
    cos, sin = rope_tables(S)
    q = apply_partial_rope(q, cos, sin) * (DIFF_HEAD_DIM ** -0.5)
    k = apply_partial_rope(k, cos, sin)
    nqb = S // Q_BLOCK
    qb = q.reshape(B, nqb, Q_BLOCK, N_DIFF_HEADS, 2, DIFF_HEAD_DIM).transpose(1, 0, 3, 4, 2, 5)
    kt = k.transpose(0, 2, 3, 1, 4)
    vt = v.transpose(0, 2, 1, 3)

    def block(qblk):
        s = jnp.einsum('bhcqd,bhckd->bhcqk', qblk, kt).astype(jnp.float32)
        a = jax.nn.softmax(s, axis=-1)
        w = a[:, :, 0] - lam * a[:, :, 1]
        return jnp.einsum('bhqk,bhkv->bhqv', w.astype(vt.dtype), vt)

    o = lax.map(block, qb)
    o = o.transpose(1, 0, 3, 2, 4).reshape(B, S, N_DIFF_HEADS, DIFF_VALUE_DIM)
    o = rms_norm(o, subln_g) * (1.0 - lambda_init)
    return o.reshape(B, S, N_DIFF_HEADS * DIFF_VALUE_DIM)


def multiscale_pool(u, w_pool, pool_scale):
    B, S = u.shape[0], u.shape[1]
    uf = u.astype(jnp.float32)
    cs = jnp.concatenate([jnp.zeros_like(uf[:, :1]), jnp.cumsum(uf, axis=1)], axis=1)
    pos = jnp.arange(S)
    outs = []
    for g, w in enumerate(POOL_WINDOWS):
        left = w // 2
        right = w - 1 - left
        lo = jnp.clip(pos - left, 0, S)
        hi = jnp.clip(pos + right + 1, 0, S)
        cnt = (hi - lo).astype(jnp.float32)
        mean = (cs[:, hi, g] - cs[:, lo, g]) / cnt[None, :, None]
        outs.append(mean - uf[:, :, g])
    d = jnp.stack(outs, axis=2).astype(u.dtype)
    y = jnp.einsum('bsgc,gcd->bsgd', d, w_pool) * pool_scale
    return y.reshape(B, S, N_POOL_GROUPS * POOL_GROUP_DIM)


def grouped_expert_ffn(xt, flat_e, flat_tok, flat_w, w_gate, w_up, w_down):
    N, D = xt.shape
    NK = flat_e.shape[0]
    order = jnp.argsort(flat_e)
    sorted_e = flat_e[order]
    counts = jax.ops.segment_sum(jnp.ones((NK,), jnp.int32), flat_e, num_segments=N_EXPERTS)
    starts = jnp.cumsum(counts) - counts
    padded = ((counts + MOE_BLOCK - 1) // MOE_BLOCK) * MOE_BLOCK
    pad_ends = jnp.cumsum(padded)
    pad_starts = pad_ends - padded
    rank = jnp.arange(NK, dtype=jnp.int32) - starts[sorted_e]
    dest = pad_starts[sorted_e] + rank
    n_blocks = -(-NK // MOE_BLOCK) + N_EXPERTS
    P = n_blocks * MOE_BLOCK
    row_tok = jnp.full((P,), N, jnp.int32).at[dest].set(flat_tok[order])
    row_w = jnp.zeros((P,), jnp.float32).at[dest].set(flat_w[order])
    block_e = jnp.minimum(
        jnp.searchsorted(pad_ends, jnp.arange(n_blocks, dtype=jnp.int32) * MOE_BLOCK, side='right'),
        N_EXPERTS - 1).astype(jnp.int32)
    x_pad = jnp.concatenate([xt, jnp.zeros((1, D), xt.dtype)], axis=0)
    xb = x_pad[row_tok].reshape(n_blocks, MOE_BLOCK, D)

    def expert_block(args):
        xblk, e = args
        hid = jax.nn.silu(xblk @ w_gate[e]) * (xblk @ w_up[e])
        return hid @ w_down[e]

    yb = lax.map(expert_block, (xb, block_e)).reshape(P, D)
    y = jnp.zeros((N + 1, D), jnp.float32).at[row_tok].add(yb.astype(jnp.float32) * row_w[:, None])
    return y[:N].astype(xt.dtype)


def hierarchical_moe(h, w_rg, b_rg, w_re, b_re, w_gate, w_up, w_down):
    B, S, D = h.shape
    N = B * S
    xt = h.reshape(N, D)
    g_logits = (xt @ w_rg).astype(jnp.float32) + b_rg.astype(jnp.float32)
    g_prob = jax.nn.softmax(g_logits, axis=-1)
    _, g_idx = lax.top_k(g_logits, 1)
    g_sel = g_idx[:, 0]
    tok = jnp.arange(N)
    g_p = g_prob[tok, g_sel]
    e_logits = ((xt @ w_re).astype(jnp.float32) + b_re.astype(jnp.float32)).reshape(N, N_EXPERT_GROUPS, EXPERTS_PER_GROUP)
    e_in = e_logits[tok, g_sel]
    e_prob = jax.nn.softmax(e_in, axis=-1)
    top_p, top_i = lax.top_k(e_prob, TOP_K_IN_GROUP)
    top_p = top_p / jnp.sum(top_p, axis=-1, keepdims=True)
    weights = g_p[:, None] * top_p
    expert_id = (g_sel[:, None] * EXPERTS_PER_GROUP + top_i).astype(jnp.int32)
    flat_tok = jnp.repeat(jnp.arange(N, dtype=jnp.int32), TOP_K_IN_GROUP)
    y = grouped_expert_ffn(xt, expert_id.reshape(-1), flat_tok, weights.reshape(-1), w_gate, w_up, w_down)
    return y.reshape(B, S, D)


def setup_inputs(seed: int = 0) -> dict:
    key = jax.random.key(seed)
    ks = jax.random.split(key, 24)
    f32 = jnp.float32
    D = D_MODEL
    nrm = lambda k, shape, s: jax.random.normal(k, shape, f32) * s
    return {
        "x": nrm(ks[0], (BATCH, SEQ, D), 1.0),
        "c": nrm(ks[1], (BATCH, D), 1.0),
        "w_ada": nrm(ks[2], (DEPTH, D, N_MOD * D), 0.3 * D ** -0.5),
        "b_ada": nrm(ks[3], (DEPTH, N_MOD * D), 0.02),
        "norm1_g": 1.0 + nrm(ks[4], (DEPTH, D), 0.02),
        "w_in": nrm(ks[5], (DEPTH, D, IN_COLS), D ** -0.5),
        "lambda_q1": nrm(ks[6], (DEPTH, DIFF_HEAD_DIM), 0.1),
        "lambda_k1": nrm(ks[7], (DEPTH, DIFF_HEAD_DIM), 0.1),
        "lambda_q2": nrm(ks[8], (DEPTH, DIFF_HEAD_DIM), 0.1),
        "lambda_k2": nrm(ks[9], (DEPTH, DIFF_HEAD_DIM), 0.1),
        "subln_g": 1.0 + nrm(ks[10], (DEPTH, DIFF_VALUE_DIM), 0.02),
        "w_pool": nrm(ks[11], (DEPTH, N_POOL_GROUPS, POOL_GROUP_DIM, POOL_GROUP_DIM), POOL_GROUP_DIM ** -0.5),
        "pool_scale": 1.0 + nrm(ks[12], (DEPTH, N_POOL_GROUPS, POOL_GROUP_DIM), 0.1),
        "w_out": nrm(ks[13], (DEPTH, MIX_WIDTH, D), MIX_WIDTH ** -0.5),
        "norm2_g": 1.0 + nrm(ks[14], (DEPTH, D), 0.02),
        "w_router_group": nrm(ks[15], (DEPTH, D, N_EXPERT_GROUPS), D ** -0.5),
        "b_router_group": nrm(ks[16], (DEPTH, N_EXPERT_GROUPS), 0.01),
        "w_router_expert": nrm(ks[17], (DEPTH, D, N_EXPERTS), D ** -0.5),
        "b_router_expert": nrm(ks[18], (DEPTH, N_EXPERTS), 0.01),
        "w_gate": nrm(ks[19], (DEPTH, N_EXPERTS, D, D_EXPERT), D ** -0.5),
        "w_up": nrm(ks[20], (DEPTH, N_EXPERTS, D, D_EXPERT), D ** -0.5),
        "w_down": nrm(ks[21], (DEPTH, N_EXPERTS, D_EXPERT, D), D_EXPERT ** -0.5),
        "final_g": 1.0 + nrm(ks[22], (D,), 0.02),
    }


def reference(x, c, w_ada, b_ada, norm1_g, w_in, lambda_q1, lambda_k1, lambda_q2, lambda_k2,
              subln_g, w_pool, pool_scale, w_out, norm2_g, w_router_group, b_router_group,
              w_router_expert, b_router_expert, w_gate, w_up, w_down, final_g):
    B, S, D = x.shape
    A = ATTN_WIDTH
    for l in range(DEPTH):
        lambda_init = lambda_init_for(l)
        mod = jax.nn.silu(c) @ w_ada[l] + b_ada[l]
        sh1, sc1, g1, sh2, sc2, g2 = jnp.split(mod, N_MOD, axis=-1)
        h = rms_norm(x, norm1_g[l]) * (1.0 + sc1[:, None]) + sh1[:, None]
        z = h @ w_in[l]
        q = z[..., :A].reshape(B, S, N_DIFF_HEADS, 2, DIFF_HEAD_DIM)
        k = z[..., A:2 * A].reshape(B, S, N_DIFF_HEADS, 2, DIFF_HEAD_DIM)
        v = z[..., 2 * A:3 * A].reshape(B, S, N_DIFF_HEADS, DIFF_VALUE_DIM)
        u = z[..., 3 * A:].reshape(B, S, N_POOL_GROUPS, POOL_GROUP_DIM)
        lam = (jnp.exp(jnp.sum(lambda_q1[l].astype(jnp.float32) * lambda_k1[l].astype(jnp.float32)))
               - jnp.exp(jnp.sum(lambda_q2[l].astype(jnp.float32) * lambda_k2[l].astype(jnp.float32)))
               + lambda_init)
        a_out = diff_attention(q, k, v, lam, subln_g[l], lambda_init)
        p_out = multiscale_pool(u, w_pool[l], pool_scale[l])
        mix = jnp.concatenate([a_out, p_out], axis=-1) @ w_out[l]
        x = x + g1[:, None] * mix
        h = rms_norm(x, norm2_g[l]) * (1.0 + sc2[:, None]) + sh2[:, None]
        y = hierarchical_moe(h, w_router_group[l], b_router_group[l], w_router_expert[l],
                             b_router_expert[l], w_gate[l], w_up[l], w_down[l])
        x = x + g2[:, None] * y
    return rms_norm(x, final_g)
```

```cpp
#include <hip/hip_runtime.h>
#include <cstdio>
#include <cstdint>

#ifndef MK_N_LAUNCHES
#define MK_N_LAUNCHES 1
#endif
#ifndef PROBE_PHASE
#define PROBE_PHASE -1
#endif
constexpr int N_PHASES = 9;
constexpr int N_LAUNCHES = MK_N_LAUNCHES;

#define GAS __attribute__((address_space(1)))
#define LAS __attribute__((address_space(3)))
typedef unsigned short bf16_t;
typedef short bf16x8 __attribute__((ext_vector_type(8)));
typedef short s16x4 __attribute__((ext_vector_type(4)));
typedef float f32x2 __attribute__((ext_vector_type(2)));
typedef float f32x4 __attribute__((ext_vector_type(4)));
typedef float f32x16 __attribute__((ext_vector_type(16)));
typedef unsigned u32x2 __attribute__((ext_vector_type(2)));
typedef unsigned u32x4 __attribute__((ext_vector_type(4)));
typedef GAS unsigned gu32;
typedef int i32x8 __attribute__((ext_vector_type(8)));
typedef int i32x4 __attribute__((ext_vector_type(4)));

constexpr int DM = 1024, NB = 16, SEQ = 2048, NTOK = NB * SEQ;
constexpr int NEXP = 32, DEXP = 512, ECAP = NTOK;
constexpr int NWAVES = 8, NTHR = NWAVES * 64;
constexpr float RMS_EPS = 1e-6f;
constexpr int MAXU = 6;

constexpr size_t MiB = 1u << 20;
constexpr size_t WS_CTL = 0, CTL_ZERO_BYTES = 1 * MiB;
constexpr size_t WS_MODP = 1 * MiB;
constexpr size_t WS_MODF = 4 * MiB;
constexpr size_t WS_GM2  = WS_MODF + 384 * 1024;
constexpr size_t WS_ROPE = WS_GM2 + 64 * 1024;
constexpr size_t WS_WRHI = WS_ROPE + 128 * 1024;
constexpr size_t WS_WRLO = WS_WRHI + 96 * 1024;
constexpr size_t WS_RINFO = 5 * MiB;
constexpr size_t WS_RW    = 9 * MiB;
constexpr size_t WS_WIN  = 13 * MiB;
constexpr size_t WS_WMIX = 17 * MiB;
constexpr size_t WS_WGU  = 19 * MiB;
constexpr size_t WS_WD   = 83 * MiB;
constexpr size_t WS_A    = 115 * MiB;
constexpr size_t WS_H1   = WS_A;
constexpr size_t WS_HID  = WS_A;
constexpr size_t WS_MIXIN = WS_A + 72 * MiB;
constexpr size_t WS_H2   = WS_A + 72 * MiB;
constexpr size_t WS_Q    = 251 * MiB;
constexpr size_t WS_K    = WS_Q + 32 * MiB;
constexpr size_t WS_V    = WS_K + 32 * MiB;
constexpr size_t WS_U    = WS_V + 32 * MiB;
constexpr size_t WS_DELTA = WS_V;
constexpr size_t WS_YS   = WS_Q;
constexpr size_t WS_END  = 379 * MiB;
constexpr int CW_BAR = 4096;
constexpr int CW_CNT = 16384;

constexpr int RING_BYTES = 139264;
constexpr int TB_TOK = RING_BYTES;
constexpr int TB_W   = TB_TOK + MAXU * 1024;
constexpr int TB_RTE = TB_W + MAXU * 1024;
constexpr int TB_RTB = TB_RTE + 1280;
constexpr int TB_CNT = TB_RTB + 160;
constexpr int TB_HIST = TB_CNT + 128;
constexpr int TB_HB  = TB_HIST + 128;
constexpr int MISC_OFF = TB_HB + 128;
constexpr int LDS_BYTES = MISC_OFF + 128;
static_assert(LDS_BYTES <= 163840 && (MISC_OFF % 16) == 0, "LDS map");

#define LDS_WAIT() asm volatile("s_waitcnt lgkmcnt(0)" ::: "memory")
#define VM_WAIT() asm volatile("s_waitcnt vmcnt(0)" ::: "memory")
#define SBAR() __builtin_amdgcn_sched_barrier(0)
__device__ __forceinline__ unsigned f2bf(float f) { unsigned u = __builtin_bit_cast(unsigned, f); return (u + 0x7fffu + ((u >> 16) & 1u)) >> 16; }
__device__ __forceinline__ unsigned pk2(float lo, float hi) { return f2bf(lo) | (f2bf(hi) << 16); }
__device__ __forceinline__ float bf2f(unsigned short b) { return __builtin_bit_cast(float, (unsigned)b << 16); }
__device__ __forceinline__ unsigned cvt_pk_bf16(float lo, float hi) { unsigned r; asm volatile("v_cvt_pk_bf16_f32 %0, %1, %2" : "=v"(r) : "v"(lo), "v"(hi)); return r; }
__device__ __forceinline__ unsigned pk4_fp8(float a, float b, float c, float d) { int w = 0; w = __builtin_amdgcn_cvt_pk_fp8_f32(a, b, w, false); w = __builtin_amdgcn_cvt_pk_fp8_f32(c, d, w, true); return (unsigned)w; }
__device__ __forceinline__ void st8_wt(void* p, u32x2 v) { __hip_atomic_store((unsigned long long*)p, ((unsigned long long)v.y << 32) | v.x, __ATOMIC_RELAXED, __HIP_MEMORY_SCOPE_AGENT); }
__device__ __forceinline__ float wave_sum(float v) {
#pragma unroll
    for (int o = 1; o < 64; o <<= 1) v += __shfl_xor(v, o);
    return v;
}

#define XB_TMO      128
#define XB_XCNT(j)  (256  + 64 * (j))
#define XB_XSUB(j)  (1280 + 64 * (j))
#define XB_XGEN(j)  (2304 + 64 * (j))
#define XB_TOP      3328
#define XB_TOPGEN   3392
#define XCD_BAR_WORDS 3456
#define XB_SPIN_CAP (1u << 18)
__device__ __forceinline__ unsigned xb_ld(unsigned* p)              { return __hip_atomic_load(p, __ATOMIC_RELAXED, __HIP_MEMORY_SCOPE_AGENT); }
__device__ __forceinline__ unsigned xb_add(unsigned* p, unsigned v) { return __hip_atomic_fetch_add(p, v, __ATOMIC_RELAXED, __HIP_MEMORY_SCOPE_AGENT); }
__device__ __forceinline__ unsigned xb_xcc_id() { return (unsigned)__builtin_amdgcn_s_getreg((3 << 11) | 20) & 0xFu; }
#define XB_SPIN(cond, bar) do { unsigned _sp = 0; while (cond) { __builtin_amdgcn_s_sleep(1); \
    if ((++_sp & 255u) == 0u) { if (xb_ld(&(bar)[XB_TMO])) break; if (_sp > XB_SPIN_CAP) { atomicAdd(&(bar)[XB_TMO], 1u); break; } } } } while (0)
struct XcdBarrier { unsigned* bar; unsigned x; volatile LAS unsigned* st; };
__device__ __forceinline__ XcdBarrier xcd_barrier_post(unsigned* bar, volatile LAS unsigned* st) {
    XcdBarrier b; b.bar = bar; b.x = xb_xcc_id(); b.st = st;
    if (threadIdx.x == 0) (void)xb_add(&bar[XB_XCNT(b.x)], 1u);
    return b;
}
__device__ __forceinline__ void xcd_barrier_complete(unsigned* bar, unsigned x, unsigned& nloc, unsigned& nx) {
    const unsigned G = gridDim.x * gridDim.y * gridDim.z;
    unsigned sum, cnt, mine, sp = 0u;
    for (;;) {
        sum = 0u; cnt = 0u; mine = 0u;
#pragma unroll
        for (unsigned j = 0; j < 16; ++j) { const unsigned c = xb_ld(&bar[XB_XCNT(j)]); sum += c; cnt += (c > 0u) ? 1u : 0u; mine = (j == x) ? c : mine; }
        if (sum == G) break;
        __builtin_amdgcn_s_sleep(1);
        if ((++sp & 255u) == 0u) { if (xb_ld(&bar[XB_TMO])) break; if (sp > XB_SPIN_CAP) { atomicAdd(&bar[XB_TMO], 1u); break; } }
    }
    nloc = mine > 0u ? mine : 1u; nx = cnt > 0u ? cnt : 1u;
}
__device__ __forceinline__ void xcd_barrier(const XcdBarrier& b) {
    asm volatile("s_waitcnt vmcnt(0)" ::: "memory");
    __syncthreads();
    if (threadIdx.x == 0) {
        unsigned* bar = b.bar;
        __builtin_amdgcn_s_waitcnt(0);
        unsigned nloc = b.st[0], nx = b.st[1];
        if (nloc == 0u) { xcd_barrier_complete(bar, b.x, nloc, nx); b.st[0] = nloc; b.st[1] = nx; }
        const unsigned old = xb_add(&bar[XB_XSUB(b.x)], 1u);
        const unsigned gen = old / nloc;
        if (old + 1u == (gen + 1u) * nloc) {
            __builtin_amdgcn_fence(__ATOMIC_RELEASE, "agent");
            asm volatile("s_waitcnt vmcnt(0)" ::: "memory");
            const unsigned og = xb_add(&bar[XB_TOP], 1u);
            const unsigned tg = og / nx;
            if (og + 1u == (tg + 1u) * nx) xb_add(&bar[XB_TOPGEN], 1u);
            else XB_SPIN(xb_ld(&bar[XB_TOPGEN]) == tg, bar);
            __builtin_amdgcn_fence(__ATOMIC_ACQUIRE, "agent");
            xb_add(&bar[XB_XGEN(b.x)], 1u);
            asm volatile("s_waitcnt vmcnt(0)" ::: "memory");
        } else {
            XB_SPIN(xb_ld(&bar[XB_XGEN(b.x)]) == gen, bar);
            __builtin_amdgcn_fence(__ATOMIC_ACQUIRE, "agent");
            asm volatile("s_waitcnt vmcnt(0)" ::: "memory");
        }
    }
    __syncthreads();
}

namespace gm {
constexpr int BM = 256, BK = 64, HALF = 128, HTB = HALF * BK * 2, STAGE_BYTES = 8 * HTB, NXCD = 8, WGM = 16;
__device__ __forceinline__ int lds_byte(int r, int c) { const int st = (r >> 4) * 2 + (c >> 5), rr = r & 15, cc = c & 31, ob = rr * 64 + cc * 2; return st * 1024 + (ob ^ (((ob >> 9) & 1) << 5)); }
__device__ __forceinline__ void stage_rc(int b, int& R, int& C) { const int st = b / 1024, sb = b % 1024, swz = sb ^ (((sb >> 9) & 1) << 5); R = (st >> 1) * 16 + swz / 64; C = (st & 1) * 32 + (swz % 64) / 2; }
__device__ __forceinline__ int perm32(int rho) { const int n = rho >> 4, i = rho & 15; return 8 * (i >> 2) + 4 * n + (i & 3); }
struct Unit { int pm, pn, e, mt, li; };

struct DenseOrder {
    int nM, nN, nwg, G, c, KB; const char* A; const char* Bt;
    __device__ __forceinline__ void init(const void* A_, const void* Bt_, int M, int N, int K_, int G_, int c_) { A = (const char*)A_; Bt = (const char*)Bt_; nM = M / BM; nN = N / BM; nwg = nM * nN; G = G_; c = c_; KB = K_ * 2; }
    __device__ __forceinline__ bool next(int i, Unit& u) const {
        const long L = (long)i * G + c; if (L >= nwg) return false;
        int wgid = (int)L; { const int q = nwg / NXCD, r = nwg % NXCD, xcd = wgid % NXCD, off = wgid / NXCD; wgid = (xcd < r ? xcd * (q + 1) : r * (q + 1) + (xcd - r) * q) + off; }
        const int nig = WGM * nN, gid = wgid / nig, fm = gid * WGM, gsz = (nM - fm) < WGM ? (nM - fm) : WGM;
        u.pm = fm + ((wgid % nig) % gsz); u.pn = (wgid % nig) / gsz; u.e = 0; u.mt = 0; u.li = i; return true;
    }
    __device__ __forceinline__ const char* abase() const { return A; }
    __device__ __forceinline__ unsigned aoff(const Unit& u, int r) const { return (unsigned)(u.pm * BM + r) * (unsigned)KB; }
    __device__ __forceinline__ const char* bptr(const Unit& u) const { return Bt + (size_t)u.pn * BM * KB; }
};
struct MoeOrder {
    const LAS int* rt_e; const LAS int* rtbase; const LAS int* tokrow; int nunits, G, c, KB; const char* A; const char* Bt; size_t bexp; bool gather;
    __device__ __forceinline__ bool next(int i, Unit& u) const {
        const long L = (long)i * G + c; if (L >= nunits) return false;
        int wgid = (int)L; { const int q = nunits / NXCD, r = nunits % NXCD, xcd = wgid % NXCD, off = wgid / NXCD; wgid = (xcd < r ? xcd * (q + 1) : r * (q + 1) + (xcd - r) * q) + off; }
        const int rt = wgid >> 2; const int e = __builtin_amdgcn_readfirstlane(rt_e[rt]); const int rb = __builtin_amdgcn_readfirstlane(rtbase[e]);
        u.pm = rt; u.pn = wgid & 3; u.e = e; u.mt = rt - rb; u.li = i; return true;
    }
    __device__ __forceinline__ const char* abase() const { return A; }
    __device__ __forceinline__ unsigned aoff(const Unit& u, int r) const {
        if (gather) { int t = tokrow[u.li * 256 + r] >> 1; t = t < 0 ? 0 : t; return (unsigned)t * (unsigned)KB; }
        return (unsigned)(u.pm * BM + r) * (unsigned)KB;
    }
    __device__ __forceinline__ const char* bptr(const Unit& u) const { return Bt + (size_t)u.e * bexp + (size_t)u.pn * BM * KB; }
};

template <class Epi, class Sched, bool F8 = false>
__device__ __forceinline__ void gemm_phase(LAS unsigned char* lds, const Sched& S, const Epi& E) {
    const int tid = threadIdx.x, wid = __builtin_amdgcn_readfirstlane(tid >> 6), lane = tid & 63, wr = wid >> 2, wc = wid & 3, fr = lane & 15, fq = lane >> 4;
    const int KB = S.KB, nt = KB / (BK * 2);
    int RA[2]; unsigned CA2[2], voffB[2];
#pragma unroll
    for (int i = 0; i < 2; ++i) { int R, C; stage_rc(tid * 16 + i * 8192, R, C); const int Rb = (R & ~31) + perm32(R & 31);
        RA[i] = R; CA2[i] = (unsigned)C * 2u; voffB[i] = (unsigned)(Rb * KB + C * 2); }
    const unsigned kstep = (unsigned)(BK * 2);
    const size_t hstep = (size_t)HALF * KB;
    const unsigned ldsw = (unsigned)wid * 1024u;
    const int aoff = lds_byte(wr * 64 + fr, fq * 8), boff = lds_byte(wc * 32 + fr, fq * 8);
#define GM_SA(b, h) (((b) * 2 + (h)) * HTB)
#define GM_SB(b, h) ((4 + (b) * 2 + (h)) * HTB)
#define GM_STAGE_B(bufoff, gbase) do { _Pragma("unroll") for (int _i = 0; _i < 2; ++_i) \
        __builtin_amdgcn_global_load_lds((const unsigned*)((const char*)(gbase) + voffB[_i]), (LAS unsigned*)(lds + (bufoff) + ldsw + _i * 8192), 16, 0, 0); } while (0)
#define GM_STAGE_A(bufoff, offs, koff) do { _Pragma("unroll") for (int _i = 0; _i < 2; ++_i) \
        __builtin_amdgcn_global_load_lds((const unsigned*)((Ab + (koff)) + (offs)[_i]), (LAS unsigned*)(lds + (bufoff) + ldsw + _i * 8192), 16, 0, 0); } while (0)
#define GM_LD8(p) __builtin_shufflevector(*(const LAS i32x4*)(p), *(const LAS i32x4*)((p) + 1024), 0, 1, 2, 3, 4, 5, 6, 7)
#define GM_LDA(dst, b, h) do { _Pragma("unroll") for (int m = 0; m < 4; ++m) { if constexpr (F8) dst##8[m] = GM_LD8(lds + GM_SA(b, h) + aoff + m * 2048); \
        else { _Pragma("unroll") for (int k = 0; k < 2; ++k) dst[m][k] = *(const LAS bf16x8*)(lds + GM_SA(b, h) + aoff + m * 2048 + k * 1024); } } } while (0)
#define GM_LDB(dst, b, h) do { _Pragma("unroll") for (int n = 0; n < 2; ++n) { if constexpr (F8) dst##8[n] = GM_LD8(lds + GM_SB(b, h) + boff + n * 2048); \
        else { _Pragma("unroll") for (int k = 0; k < 2; ++k) dst[n][k] = *(const LAS bf16x8*)(lds + GM_SB(b, h) + boff + n * 2048 + k * 1024); } } } while (0)
#define GM_MMA(ai, bj, At, Bt) do { __builtin_amdgcn_s_setprio(1); _Pragma("unroll") for (int m = 0; m < 4; ++m) _Pragma("unroll") for (int n = 0; n < 2; ++n) { \
        if constexpr (F8) asm volatile("v_mfma_scale_f32_16x16x128_f8f6f4 %0, %1, %2, %0, %3, %4 op_sel_hi:[0,0,0]" : "+v"(acc[ai][bj][m][n]) : "v"(Bt##8[n]), "v"(At##8[m]), "v"(scW), "v"(scX)); \
        else { _Pragma("unroll") for (int k = 0; k < 2; ++k) acc[ai][bj][m][n] = __builtin_amdgcn_mfma_f32_16x16x32_bf16(Bt[n][k], At[m][k], acc[ai][bj][m][n], 0, 0, 0); } } \
        __builtin_amdgcn_s_setprio(0); } while (0)
#define GM_WAIT_V(n) asm volatile("s_waitcnt vmcnt(" #n ")" ::: "memory")
#define GM_WAIT_L(n) asm volatile("s_waitcnt lgkmcnt(" #n ")" ::: "memory")
#define GM_BAR __builtin_amdgcn_s_barrier()
    Unit cur, nxt; int ui = 0;
    if (!S.next(0, cur)) return;
    f32x4 acc[2][2][4][2];
#pragma unroll
    for (int a = 0; a < 2; ++a)
#pragma unroll
        for (int b = 0; b < 2; ++b)
#pragma unroll
            for (int m = 0; m < 4; ++m)
#pragma unroll
                for (int n = 0; n < 2; ++n) acc[a][b][m][n] = (f32x4){0.f, 0.f, 0.f, 0.f};
    bf16x8 At[4][2], B0[2][2], B1[2][2]; i32x8 At8[4], B08[2], B18[2];
    int scW = 0x7A7A7A7A, scX = 0x7F7F7F7F; asm volatile("" : "+v"(scW), "+v"(scX));
    const char* Ab = S.abase();
    unsigned coff[2][2], noff[2][2];
#pragma unroll
    for (int h = 0; h < 2; ++h)
#pragma unroll
        for (int i = 0; i < 2; ++i) coff[h][i] = S.aoff(cur, h * HALF + RA[i]) + CA2[i];
    const char* cB = S.bptr(cur);
    GM_STAGE_B(GM_SB(0, 0), cB); GM_STAGE_B(GM_SB(0, 1), cB + hstep); GM_STAGE_A(GM_SA(0, 0), coff[0], 0u); GM_STAGE_A(GM_SA(0, 1), coff[1], 0u);
    if (wr == 1) GM_BAR;
    GM_WAIT_V(2); GM_BAR;
    GM_STAGE_B(GM_SB(1, 0), cB + kstep); GM_STAGE_A(GM_SA(1, 0), coff[0], kstep); GM_STAGE_B(GM_SB(1, 1), cB + hstep + kstep);
    GM_WAIT_V(6); GM_BAR;
    for (;;) {
        const bool has_next = S.next(ui + 1, nxt);
        const char* nB = has_next ? S.bptr(nxt) : cB;
#pragma unroll
        for (int h = 0; h < 2; ++h)
#pragma unroll
            for (int i = 0; i < 2; ++i) noff[h][i] = has_next ? (S.aoff(nxt, h * HALF + RA[i]) + CA2[i]) : coff[h][i];
        for (int t = 0; t < nt; t += 2) {
            const bool last = (t == nt - 2);
            const unsigned k1 = (unsigned)(t + 1) * kstep;
            const unsigned k2 = last ? 0u : (unsigned)(t + 2) * kstep, k3 = k2 + kstep;
            const char* b2 = last ? nB : cB + (size_t)(t + 2) * kstep; const char* b3 = b2 + kstep;
            unsigned s2[2][2];
#pragma unroll
            for (int h = 0; h < 2; ++h)
#pragma unroll
                for (int i = 0; i < 2; ++i) s2[h][i] = last ? noff[h][i] : coff[h][i];
            GM_LDB(B0, 0, 0); GM_LDB(B1, 0, 1); SBAR(); GM_LDA(At, 0, 0); GM_STAGE_A(GM_SA(1, 1), coff[1], k1);
            GM_WAIT_V(8); GM_WAIT_L(0); GM_BAR; GM_MMA(0, 0, At, B0); GM_MMA(0, 1, At, B1); GM_BAR; SBAR();
            GM_LDA(At, 0, 1); GM_STAGE_B(GM_SB(0, 0), b2); GM_STAGE_B(GM_SB(0, 1), b2 + hstep); GM_STAGE_A(GM_SA(0, 0), s2[0], k2);
            GM_WAIT_V(8); GM_WAIT_L(0); GM_BAR; GM_MMA(1, 0, At, B0); GM_MMA(1, 1, At, B1); GM_BAR; SBAR();
            GM_LDB(B0, 1, 0); GM_LDB(B1, 1, 1); SBAR(); GM_LDA(At, 1, 0); GM_STAGE_A(GM_SA(0, 1), s2[1], k2);
            GM_WAIT_V(8); GM_WAIT_L(0); GM_BAR; GM_MMA(0, 0, At, B0); GM_MMA(0, 1, At, B1); GM_BAR; SBAR();
            GM_LDA(At, 1, 1); GM_STAGE_B(GM_SB(1, 0), b3); GM_STAGE_B(GM_SB(1, 1), b3 + hstep); GM_STAGE_A(GM_SA(1, 0), s2[0], k3);
            GM_WAIT_V(8); GM_WAIT_L(0); GM_BAR; GM_MMA(1, 0, At, B0); GM_MMA(1, 1, At, B1); GM_BAR; SBAR();
        }
        if (wr == 0) GM_BAR;
        if constexpr (F8) asm volatile("s_nop 15\n\ts_nop 15" ::: "memory");
        E(acc, cur, wr, wc, fr, fq);
        if (!has_next) break;
#pragma unroll
        for (int a = 0; a < 2; ++a)
#pragma unroll
            for (int b = 0; b < 2; ++b)
#pragma unroll
                for (int m = 0; m < 4; ++m)
#pragma unroll
                    for (int n = 0; n < 2; ++n) acc[a][b][m][n] = (f32x4){0.f, 0.f, 0.f, 0.f};
        cur = nxt; cB = nB; ++ui;
#pragma unroll
        for (int h = 0; h < 2; ++h)
#pragma unroll
            for (int i = 0; i < 2; ++i) coff[h][i] = noff[h][i];
        if (wr == 1) GM_BAR;
    }
    GM_WAIT_V(0);
    GM_BAR;
#undef GM_SA
#undef GM_SB
#undef GM_STAGE_A
#undef GM_STAGE_B
#undef GM_LD8
#undef GM_LDA
#undef GM_LDB
#undef GM_MMA
#undef GM_WAIT_V
#undef GM_WAIT_L
#undef GM_BAR
}

constexpr float QSCALE = 0.125f * 1.4426950408889634f;
struct EpiQKVU {
    bf16_t* Q; bf16_t* Kb; bf16_t* V; bf16_t* U; const float* rope;
    __device__ __forceinline__ void operator()(const f32x4 (&acc)[2][2][4][2], const Unit& u, int wr, int wc, int fr, int fq) const {
        const int kind = u.pn >> 1;
        bf16_t* base = kind == 0 ? Q : (kind == 1 ? Kb : (kind == 2 ? V : U));
        const int row0 = u.pm * BM + wr * 64 + fr, col0 = (u.pn & 1) * 256 + wc * 32 + 8 * fq;
        const bool dorope = (kind < 2) && ((wc & 1) == 0);
#pragma unroll
        for (int ai = 0; ai < 2; ++ai)
#pragma unroll
            for (int m = 0; m < 4; ++m) {
                const int row = row0 + ai * HALF + m * 16;
                bf16_t* rowp = base + (size_t)row * 512 + col0;
                f32x4 c0 = {1.f, 1.f, 1.f, 1.f}, c1 = c0, s0 = {0.f, 0.f, 0.f, 0.f}, s1 = s0;
                if (dorope) { const float* rp = rope + (size_t)(row & (SEQ - 1)) * 16; c0 = *(const f32x4*)(rp); c1 = *(const f32x4*)(rp + 4); s0 = *(const f32x4*)(rp + 8); s1 = *(const f32x4*)(rp + 12);
                    if (fq == 0) { s0 = -s0; s1 = -s1; } if (fq >= 2) { c0 = (f32x4){1.f, 1.f, 1.f, 1.f}; c1 = c0; s0 = (f32x4){0.f, 0.f, 0.f, 0.f}; s1 = s0; } }
#pragma unroll
                for (int bj = 0; bj < 2; ++bj) {
                    f32x4 v0 = acc[ai][bj][m][0], v1 = acc[ai][bj][m][1];
                    if (dorope) {
                        f32x4 p0, p1;
#pragma unroll
                        for (int j = 0; j < 4; ++j) { p0[j] = __shfl_xor(v0[j], 16); p1[j] = __shfl_xor(v1[j], 16); }
                        v0 = v0 * c0 + p0 * s0; v1 = v1 * c1 + p1 * s1;
                    }
                    if (kind == 0) { v0 = v0 * QSCALE; v1 = v1 * QSCALE; }
                    u32x4 w; w.x = cvt_pk_bf16(v0[0], v0[1]); w.y = cvt_pk_bf16(v0[2], v0[3]); w.z = cvt_pk_bf16(v1[0], v1[1]); w.w = cvt_pk_bf16(v1[2], v1[3]);
                    *(u32x4*)(rowp + bj * HALF) = w;
                }
            }
    }
};
struct EpiMix {
    bf16_t* D; const float* g1;
    __device__ __forceinline__ void operator()(const f32x4 (&acc)[2][2][4][2], const Unit& u, int wr, int wc, int fr, int fq) const {
        const int row0 = u.pm * BM + wr * 64 + fr, col0 = u.pn * BM + wc * 32 + 8 * fq, b = (u.pm * BM) >> 11;
        f32x4 gv[2][2];
#pragma unroll
        for (int bj = 0; bj < 2; ++bj)
#pragma unroll
            for (int n = 0; n < 2; ++n) gv[bj][n] = *(const f32x4*)(g1 + (size_t)b * 6144 + col0 + bj * HALF + 4 * n);
#pragma unroll
        for (int ai = 0; ai < 2; ++ai)
#pragma unroll
            for (int m = 0; m < 4; ++m) { bf16_t* rowp = D + (size_t)(row0 + ai * HALF + m * 16) * DM + col0;
#pragma unroll
                for (int bj = 0; bj < 2; ++bj) { const f32x4 v0 = gv[bj][0] * acc[ai][bj][m][0], v1 = gv[bj][1] * acc[ai][bj][m][1];
                    u32x4 w; w.x = cvt_pk_bf16(v0[0], v0[1]); w.y = cvt_pk_bf16(v0[2], v0[3]); w.z = cvt_pk_bf16(v1[0], v1[1]); w.w = cvt_pk_bf16(v1[2], v1[3]);
                    *(u32x4*)(rowp + bj * HALF) = w; } }
    }
};
struct EpiGateUp {
    unsigned char* HID;
    __device__ __forceinline__ void operator()(const f32x4 (&acc)[2][2][4][2], const Unit& u, int wr, int wc, int fr, int fq) const {
        const int row0 = u.pm * BM + wr * 64 + fr, col0 = u.pn * HALF + wc * 32 + 8 * fq;
#pragma unroll
        for (int ai = 0; ai < 2; ++ai)
#pragma unroll
            for (int m = 0; m < 4; ++m) { float h[8];
#pragma unroll
                for (int n = 0; n < 2; ++n)
#pragma unroll
                    for (int j = 0; j < 4; ++j) { const float g = acc[ai][0][m][n][j], up = acc[ai][1][m][n][j];
                        h[n * 4 + j] = g * up * __builtin_amdgcn_rcpf(1.f + __builtin_amdgcn_exp2f(-1.4426950408889634f * g)); }
                u32x2 w; w.x = pk4_fp8(h[0], h[1], h[2], h[3]); w.y = pk4_fp8(h[4], h[5], h[6], h[7]);
                st8_wt(HID + (size_t)(row0 + ai * HALF + m * 16) * DEXP + col0, w); }
    }
};
struct EpiDown {
    unsigned char* YS; const LAS int* tokrow; const LAS float* wrow;
    __device__ __forceinline__ void operator()(const f32x4 (&acc)[2][2][4][2], const Unit& u, int wr, int wc, int fr, int fq) const {
        const int r0 = wr * 64 + fr, col0 = u.pn * BM + wc * 32 + 8 * fq;
#pragma unroll
        for (int ai = 0; ai < 2; ++ai)
#pragma unroll
            for (int m = 0; m < 4; ++m) { const int r = r0 + ai * HALF + m * 16; const int dest = tokrow[u.li * 256 + r]; const float w8 = wrow[u.li * 256 + r];
                if (dest >= 0) {
#pragma unroll
                    for (int bj = 0; bj < 2; ++bj) { const f32x4 v0 = acc[ai][bj][m][0] * (w8 * 16.f), v1 = acc[ai][bj][m][1] * (w8 * 16.f);
                        u32x2 w; w.x = pk4_fp8(v0[0], v0[1], v0[2], v0[3]); w.y = pk4_fp8(v1[0], v1[1], v1[2], v1[3]);
                        st8_wt(YS + (size_t)dest * DM + col0 + bj * HALF, w); } } }
    }
};
}

namespace att {
constexpr int QBLK = 32, KVBLK = 64, LDK = 512;
constexpr float THRL = 8.f;
constexpr int SHM_V = KVBLK * 128 * 2, SHM_K = KVBLK * 128 * 2;
constexpr int SLOT = SHM_V + SHM_K, NSLOT = 3;
constexpr int OFF_WS = NSLOT * SLOT, OFF_XCH = 0  , ATT_LDS = OFF_WS + NWAVES * 64 * 4;
static_assert(4 * 64 * 64 * 4 <= 2 * SLOT, "exchange block fits two ring slots");
static_assert(ATT_LDS <= RING_BYTES, "attention LDS");
#define KSWZ(row, colB) ((row) * 256 + ((colB) ^ (((row) & 7) << 4)))
__device__ __forceinline__ int crow(int r, int hi) { return (r & 3) + 8 * (r >> 2) + 4 * hi; }
template <bool FIRST>
__device__ __forceinline__ void partialSM(f32x16& p0, f32x16& p1, float& mhat, float& alpha) {
    float a = fmaxf(fmaxf(p0[0], p0[1]), p1[0]), b = fmaxf(fmaxf(p0[2], p0[3]), p1[1]); a = fmaxf(fmaxf(a, p1[2]), p1[3]);
#pragma unroll
    for (int r = 4; r < 16; r += 4) { a = fmaxf(fmaxf(a, p0[r]), p0[r + 1]); b = fmaxf(fmaxf(b, p0[r + 2]), p0[r + 3]); a = fmaxf(fmaxf(a, p1[r]), p1[r + 1]); b = fmaxf(fmaxf(b, p1[r + 2]), p1[r + 3]); }
    float pmax = fmaxf(a, b);
    { auto rr = __builtin_amdgcn_permlane32_swap(__float_as_uint(pmax), __float_as_uint(pmax), false, false); pmax = fmaxf(__uint_as_float(rr[0]), __uint_as_float(rr[1])); }
    alpha = 1.f;
    if (FIRST || !__builtin_expect(__all(pmax <= THRL), 1)) {
        const float dl = FIRST ? pmax : fmaxf(pmax, 0.f);
        mhat += dl;
#pragma unroll
        for (int r = 0; r < 16; ++r) { p0[r] -= dl; p1[r] -= dl; }
        if (!FIRST) alpha = __builtin_amdgcn_exp2f(-dl);
    }
#pragma unroll
    for (int r = 0; r < 16; ++r) p0[r] = __builtin_amdgcn_exp2f(p0[r]);
}
__device__ __forceinline__ void finishSM(f32x16& p0, f32x16& p1, float alpha, float& l_reg, bf16x8& pa0, bf16x8& pa1, bf16x8& pa2, bf16x8& pa3) {
#pragma unroll
    for (int r = 0; r < 16; ++r) p1[r] = __builtin_amdgcn_exp2f(p1[r]);
    float ps = 0;
#pragma unroll
    for (int r = 0; r < 16; ++r) ps += p0[r];
#pragma unroll
    for (int r = 0; r < 16; ++r) ps += p1[r];
    { auto rr = __builtin_amdgcn_permlane32_swap(__float_as_uint(ps), __float_as_uint(ps), false, false); ps = __uint_as_float(rr[0]) + __uint_as_float(rr[1]); }
    l_reg = l_reg * alpha + ps;
#define PK4(P, BASE, OUT) do { unsigned a0 = cvt_pk_bf16(P[BASE + 0], P[BASE + 1]), a1 = cvt_pk_bf16(P[BASE + 2], P[BASE + 3]);   \
    unsigned b0 = cvt_pk_bf16(P[BASE + 4], P[BASE + 5]), b1 = cvt_pk_bf16(P[BASE + 6], P[BASE + 7]);                              \
    auto r0 = __builtin_amdgcn_permlane32_swap(a0, b0, false, false); auto r1 = __builtin_amdgcn_permlane32_swap(a1, b1, false, false); \
    u32x4 w = {r0[0], r1[0], r0[1], r1[1]}; OUT = *reinterpret_cast<bf16x8*>(&w); } while (0)
    PK4(p0, 0, pa0); PK4(p0, 8, pa1); PK4(p1, 0, pa2); PK4(p1, 8, pa3);
#undef PK4
}
__device__ __forceinline__ void qkt(f32x16& p0, f32x16& p1, const char* Ks, const bf16x8* qr, const float mhat, int r32, int hi, int kc0) {
    f32x16 negm;
#pragma unroll
    for (int r = 0; r < 16; ++r) negm[r] = -mhat;
#pragma unroll
    for (int d0 = 0; d0 < 4; ++d0) { const int cb = (kc0 + d0 * 16 + hi * 8) * 2;
        const bf16x8 b0 = *reinterpret_cast<const bf16x8*>(Ks + KSWZ(r32, cb));
        const bf16x8 b1 = *reinterpret_cast<const bf16x8*>(Ks + KSWZ(32 + r32, cb));
        if (d0 == 0) { p0 = __builtin_amdgcn_mfma_f32_32x32x16_bf16(b0, qr[0], negm, 0, 0, 0); p1 = __builtin_amdgcn_mfma_f32_32x32x16_bf16(b1, qr[0], negm, 0, 0, 0); }
        else { p0 = __builtin_amdgcn_mfma_f32_32x32x16_bf16(b0, qr[d0], p0, 0, 0, 0); p1 = __builtin_amdgcn_mfma_f32_32x32x16_bf16(b1, qr[d0], p1, 0, 0, 0); } }
}
__device__ __forceinline__ int v_st(int k, int c) { const int kk = (k & ~0xC) | ((k & 4) << 1) | ((k & 8) >> 1); return ((kk >> 3) * 4 + (c >> 5)) * 512 + ((kk & 7) * 32 + (c & 31)) * 2; }
__device__ __forceinline__ int v_rd_base(int lane) { return ((lane & 3) << 3) | (((lane >> 2) & 3) << 6) | (((lane >> 4) & 1) << 5) | (((lane >> 5) & 1) << 8); }
constexpr int v_rd_off(int d0, int ks, int half) { return d0 * 512 + ks * 4096 + half * 2048; }
template <int OFF> __device__ __forceinline__ s16x4 tr_read(int vb) { s16x4 r; asm volatile("ds_read_b64_tr_b16 %0, %1 offset:%2" : "=&v"(r) : "v"(vb), "i"(OFF) : "memory"); return r; }
struct VFrag { s16x4 l0, h0, l1, h1, l2, h2, l3, h3; };
template <int D0> __device__ __forceinline__ void v_reads(VFrag& f, int vb) {
    f.l0 = tr_read<v_rd_off(D0, 0, 0)>(vb); f.h0 = tr_read<v_rd_off(D0, 0, 1)>(vb); f.l1 = tr_read<v_rd_off(D0, 1, 0)>(vb); f.h1 = tr_read<v_rd_off(D0, 1, 1)>(vb);
    f.l2 = tr_read<v_rd_off(D0, 2, 0)>(vb); f.h2 = tr_read<v_rd_off(D0, 2, 1)>(vb); f.l3 = tr_read<v_rd_off(D0, 3, 0)>(vb); f.h3 = tr_read<v_rd_off(D0, 3, 1)>(vb);
}
__device__ __forceinline__ void pv_mma(f32x16& od, const VFrag& f, bf16x8 pa0, bf16x8 pa1, bf16x8 pa2, bf16x8 pa3) {
#define PK(L, H) (bf16x8){L[0], L[1], L[2], L[3], H[0], H[1], H[2], H[3]}
    od = __builtin_amdgcn_mfma_f32_32x32x16_bf16(pa0, PK(f.l0, f.h0), od, 0, 0, 0);
    od = __builtin_amdgcn_mfma_f32_32x32x16_bf16(pa1, PK(f.l1, f.h1), od, 0, 0, 0);
    od = __builtin_amdgcn_mfma_f32_32x32x16_bf16(pa2, PK(f.l2, f.h2), od, 0, 0, 0);
    od = __builtin_amdgcn_mfma_f32_32x32x16_bf16(pa3, PK(f.l3, f.h3), od, 0, 0, 0);
#undef PK
}
__device__ __forceinline__ void pv_d0(f32x16* o, int vb, bf16x8 pa0, bf16x8 pa1, bf16x8 pa2, bf16x8 pa3) {
    VFrag fa, fb;
    v_reads<0>(fa, vb);
    asm volatile("s_waitcnt lgkmcnt(0)" ::: "memory"); SBAR();
    v_reads<1>(fb, vb); SBAR();
    pv_mma(o[0], fa, pa0, pa1, pa2, pa3); SBAR();
    asm volatile("s_waitcnt lgkmcnt(0)" ::: "memory"); SBAR();
    v_reads<2>(fa, vb); SBAR();
    pv_mma(o[1], fb, pa0, pa1, pa2, pa3); SBAR();
    asm volatile("s_waitcnt lgkmcnt(0)" ::: "memory"); SBAR();
    v_reads<3>(fb, vb); SBAR();
    pv_mma(o[2], fa, pa0, pa1, pa2, pa3); SBAR();
    asm volatile("s_waitcnt lgkmcnt(0)" ::: "memory"); SBAR();
    pv_mma(o[3], fb, pa0, pa1, pa2, pa3);
}
constexpr int OFF_LAND = OFF_WS + NWAVES * 64 * 4;
static_assert(OFF_LAND + NWAVES * 4096 <= RING_BYTES, "landing buffers fit the phase scratch");
struct Weave { const float* wg; const float* wu; const float* wd; unsigned char* dgu; unsigned char* dd; int next, end, pend; };
__device__ __forceinline__ void weave_decode(const Weave& W, int B, int wid, const float*& src, int& ldw, unsigned char*& dst, int& ldd, int& n0, int& isup, int& type) {
    const int mat = B >> 6, within = B & 63, e = mat & 31; type = mat >> 5;
    int kblk, nblk;
    if (type < 2) { src = (type ? W.wu : W.wg) + (size_t)e * DM * DEXP; ldw = DEXP; kblk = within >> 3; nblk = within & 7; dst = W.dgu + (size_t)e * DM * DM; ldd = DM; }
    else { src = W.wd + (size_t)e * DEXP * DM; ldw = DM; kblk = within >> 4; nblk = within & 15; dst = W.dd + (size_t)e * DM * DEXP; ldd = DEXP; }
    isup = type == 1; n0 = nblk * 64;
    src += (size_t)(kblk * 128 + wid * 16) * ldw + n0; dst += kblk * 128 + wid * 16;
}
__device__ __forceinline__ void weave_step(Weave& W, char* lds, LAS unsigned char* ldsl, int wid, int lane) {
    if (W.pend >= 0) {
        const float* src; int ldw, ldd, n0, isup, type; unsigned char* dst;
        weave_decode(W, W.pend, wid, src, ldw, dst, ldd, n0, isup, type);
        const float* land = (const float*)(lds + OFF_LAND + wid * 4096) + lane;
        float v[16];
#pragma unroll
        for (int i = 0; i < 16; ++i) v[i] = land[i * 64] * 32.f;
        u32x4 o; o.x = pk4_fp8(v[0], v[1], v[2], v[3]); o.y = pk4_fp8(v[4], v[5], v[6], v[7]); o.z = pk4_fp8(v[8], v[9], v[10], v[11]); o.w = pk4_fp8(v[12], v[13], v[14], v[15]);
        const int n = n0 + lane; const int drow = type < 2 ? (256 * (n >> 7) + 128 * isup + (n & 127)) : n;
        *(GAS u32x4*)(dst + (size_t)drow * ldd) = o;
        asm volatile("s_waitcnt lgkmcnt(0)" ::: "memory");
        W.pend = -1;
    }
    if (W.next < W.end) {
        const float* src; int ldw, ldd, n0, isup, type; unsigned char* dst;
        weave_decode(W, W.next, wid, src, ldw, dst, ldd, n0, isup, type);
        const float* sp = src + lane;
#pragma unroll
        for (int i = 0; i < 16; ++i) __builtin_amdgcn_global_load_lds((const unsigned*)(sp + (size_t)i * ldw), (LAS unsigned*)(ldsl + OFF_LAND + wid * 4096 + i * 256), 4, 0, 0);
        W.pend = W.next; ++W.next;
    }
}
__device__ __forceinline__ void attn_unit(const bf16_t* __restrict__ Qg, const bf16_t* __restrict__ Kg, const bf16_t* __restrict__ Vg, bf16_t* MIX,
                                          int b, int h, int qblk, float lam, const float* __restrict__ subg, char* lds, LAS unsigned char* ldsl, Weave& wv) {
    const int tid = threadIdx.x, wid = __builtin_amdgcn_readfirstlane(tid >> 6), lane = tid & 63, r32 = lane & 31, hi = lane >> 5;
    const int comp = wid >> 2, wq = wid & 3;
    float* wsf = (float*)(lds + OFF_WS) + wid * 64; float* li_l = wsf; float* al_l = wsf + 32;
    float* xch = (float*)(lds + OFF_XCH) + wq * 4096;
    const long tok0 = (long)b * SEQ;
    float mhat = 0.f, l_reg = 0; f32x16 o[4] = {}; bf16x8 qr[4];
    const bf16_t* Qw = Qg + (tok0 + qblk * 128 + wq * QBLK + r32) * 512 + h * 128 + comp * 64 + hi * 8;
#pragma unroll
    for (int d0 = 0; d0 < 4; ++d0) qr[d0] = *reinterpret_cast<const bf16x8*>(Qw + d0 * 16);
    const char* Kb = (const char*)(Kg + tok0 * 512 + h * 128); const char* Vb = (const char*)(Vg + tok0 * 512 + h * 128);
    unsigned koff[2], voff[2];
#pragma unroll
    for (int i = 0; i < 2; ++i) { const int p_ = (wid * 2 + i) * 1024 + 16 * lane;
        { const int row = p_ >> 8, colB = (p_ & 255) ^ ((row & 7) << 4); koff[i] = (unsigned)(row * 1024 + colB); }
        { const int sub = p_ >> 9, kk = (sub >> 2) * 8 + ((p_ & 511) >> 6), c = (sub & 3) * 32 + (((p_ & 511) >> 1) & 31);
          const int k = (kk & ~0xC) | ((kk & 4) << 1) | ((kk & 8) >> 1); voff[i] = (unsigned)(k * 1024 + c * 2); } }
    const int vb0 = (int)(uintptr_t)lds + v_rd_base(lane);
    const int kc0 = comp * 64;
#define DMA_TILE(t, so) do { const char* kb_ = Kb + (size_t)(t) * (KVBLK * 1024); const char* vb_ = Vb + (size_t)(t) * (KVBLK * 1024); \
    _Pragma("unroll") for (int i_ = 0; i_ < 2; ++i_) { \
        __builtin_amdgcn_global_load_lds((const unsigned*)(vb_ + voff[i_]), (LAS unsigned*)(ldsl + (so) + (wid * 2 + i_) * 1024), 16, 0, 0); \
        __builtin_amdgcn_global_load_lds((const unsigned*)(kb_ + koff[i_]), (LAS unsigned*)(ldsl + (so) + SHM_V + (wid * 2 + i_) * 1024), 16, 0, 0); } } while (0)
#define WAIT_BAR(N) asm volatile("s_waitcnt vmcnt(" #N ") lgkmcnt(0)\n\ts_barrier" ::: "memory")
#define RESC(a) do { if (__any((a) < 1.f)) { if (hi == 0) al_l[r32] = (a); asm volatile("s_waitcnt lgkmcnt(0)" ::: "memory"); \
    _Pragma("unroll") for (int d = 0; d < 4; ++d) _Pragma("unroll") for (int r = 0; r < 16; ++r) o[d][r] *= al_l[crow(r, hi)]; } } while (0)
    f32x16 pA0, pA1, pB0, pB1; float alA, alB; bf16x8 pa0, pa1, pa2, pa3; constexpr int NT = SEQ / KVBLK;
    DMA_TILE(0, 0); DMA_TILE(1, SLOT);
    WAIT_BAR(4);
    qkt(pA0, pA1, lds + SHM_V, qr, mhat, r32, hi, kc0); partialSM<true>(pA0, pA1, mhat, alA);
    DMA_TILE(2, 2 * SLOT);
    WAIT_BAR(4);
    int s_prev = 0, s_cur = SLOT, s_next = 2 * SLOT;
#define ROT() do { const int t_ = s_prev; s_prev = s_cur; s_cur = s_next; s_next = t_; } while (0)
    for (int j = 1; j + 1 < NT; j += 2) {
        SBAR(); qkt(pB0, pB1, lds + s_cur + SHM_V, qr, mhat, r32, hi, kc0);
        finishSM(pA0, pA1, alA, l_reg, pa0, pa1, pa2, pa3); SBAR();
        pv_d0(o, vb0 + s_prev, pa0, pa1, pa2, pa3); partialSM<false>(pB0, pB1, mhat, alB);
        WAIT_BAR(0);
        if (j + 2 < NT) DMA_TILE(j + 2, s_prev);
        RESC(alB); ROT();
        SBAR(); qkt(pA0, pA1, lds + s_cur + SHM_V, qr, mhat, r32, hi, kc0);
        finishSM(pB0, pB1, alB, l_reg, pa0, pa1, pa2, pa3); SBAR();
        pv_d0(o, vb0 + s_prev, pa0, pa1, pa2, pa3); partialSM<false>(pA0, pA1, mhat, alA);
        WAIT_BAR(0);
        if (j + 3 < NT) DMA_TILE(j + 3, s_prev);
        weave_step(wv, lds, ldsl, wid, lane);
        RESC(alA); ROT();
    }
    SBAR(); qkt(pB0, pB1, lds + s_cur + SHM_V, qr, mhat, r32, hi, kc0);
    finishSM(pA0, pA1, alA, l_reg, pa0, pa1, pa2, pa3); SBAR();
    pv_d0(o, vb0 + s_prev, pa0, pa1, pa2, pa3); partialSM<false>(pB0, pB1, mhat, alB);
    RESC(alB);
    finishSM(pB0, pB1, alB, l_reg, pa0, pa1, pa2, pa3); SBAR();
    pv_d0(o, vb0 + s_cur, pa0, pa1, pa2, pa3);
    asm volatile("s_waitcnt lgkmcnt(0)\n\ts_barrier" ::: "memory");
    if (hi == 0) li_l[r32] = l_reg; asm volatile("s_waitcnt lgkmcnt(0)" ::: "memory");
    float rli[16];
#pragma unroll
    for (int r = 0; r < 16; ++r) rli[r] = __builtin_amdgcn_rcpf(li_l[crow(r, hi)]);
    if (comp == 1) {
#pragma unroll
        for (int d0 = 0; d0 < 4; ++d0)
#pragma unroll
            for (int r = 0; r < 16; ++r) xch[(d0 * 16 + r) * 64 + lane] = o[d0][r] * rli[r];
    }
    __syncthreads();
    if (comp == 0) {
        float rn[16];
#pragma unroll
        for (int r = 0; r < 16; ++r) { float s = 0.f;
#pragma unroll
            for (int d0 = 0; d0 < 4; ++d0) { const float v = o[d0][r] * rli[r] - lam * xch[(d0 * 16 + r) * 64 + lane]; o[d0][r] = v; s += v * v; }
            s += __shfl_xor(s, 1); s += __shfl_xor(s, 2); s += __shfl_xor(s, 4); s += __shfl_xor(s, 8); s += __shfl_xor(s, 16);
            rn[r] = __builtin_amdgcn_rsqf(s * (1.f / 128.f) + RMS_EPS) * 0.8f; }
        float gs[4];
#pragma unroll
        for (int d0 = 0; d0 < 4; ++d0) gs[d0] = subg[d0 * 32 + r32];
        asm volatile("s_waitcnt lgkmcnt(0)" ::: "memory");
        bf16_t* stg = (bf16_t*)xch;
#pragma unroll
        for (int r = 0; r < 16; ++r) { const int orow = crow(r, hi);
#pragma unroll
            for (int d0 = 0; d0 < 4; ++d0) stg[orow * 128 + d0 * 32 + r32] = (bf16_t)f2bf(o[d0][r] * rn[r] * gs[d0]); }
        asm volatile("s_waitcnt lgkmcnt(0)" ::: "memory");
        bf16_t* Ow = MIX + (tok0 + qblk * 128 + wq * QBLK) * 1024 + h * 128;
#pragma unroll
        for (int i = 0; i < 8; ++i) { const int row = i * 4 + (lane >> 4), ch = lane & 15; const u32x4 v = *(const u32x4*)(stg + row * 128 + ch * 8); *(u32x4*)(Ow + (long)row * 1024 + ch * 8) = v; }
    }
    asm volatile("s_waitcnt lgkmcnt(0)" ::: "memory");
    __syncthreads();
#undef DMA_TILE
#undef WAIT_BAR
#undef ROT
#undef RESC
}
#undef KSWZ
}

struct Params {
    const float *x, *c, *w_ada, *b_ada, *norm1_g, *w_in, *lq1, *lk1, *lq2, *lk2, *subln_g, *w_pool, *pool_scale, *w_out, *norm2_g, *w_rg, *b_rg, *w_re, *b_re, *w_gate, *w_up, *w_down, *final_g;
    float* out; unsigned char* ws; long long ph;
};
struct Frame { LAS unsigned char* lds; int tid, lane, wave, vcu, G; };

__device__ __forceinline__ void transpose_item(const float* W, int ldw, int k0, int n0, bf16_t* WT, size_t drow0, int ldd, int dcol0, LAS float* scr, int lane) {
#pragma unroll 8
    for (int i = 0; i < 32; ++i) { const int kk = 2 * i + (lane >> 5); scr[kk * 33 + (lane & 31)] = W[(size_t)(k0 + kk) * ldw + n0 + (lane & 31)]; }
    LDS_WAIT(); asm volatile("" ::: "memory");
    const int c = lane & 7;
#pragma unroll
    for (int j = 0; j < 4; ++j) { const int n = (lane >> 3) + 8 * j; const LAS float* s = scr + (8 * c) * 33 + n;
        u32x4 o; o.x = cvt_pk_bf16(s[0 * 33], s[1 * 33]); o.y = cvt_pk_bf16(s[2 * 33], s[3 * 33]); o.z = cvt_pk_bf16(s[4 * 33], s[5 * 33]); o.w = cvt_pk_bf16(s[6 * 33], s[7 * 33]);
        *(GAS u32x4*)(WT + (drow0 + n) * (size_t)ldd + dcol0 + 8 * c) = o; }
    LDS_WAIT(); asm volatile("" ::: "memory");
}
__device__ __forceinline__ void transpose_item_f8(const float* W, int ldw, int k0, int n0, unsigned char* WT, size_t drow0, int ldd, int dcol0, LAS float* scr, int lane) {
#pragma unroll 8
    for (int i = 0; i < 32; ++i) { const int kk = 2 * i + (lane >> 5); scr[kk * 33 + (lane & 31)] = W[(size_t)(k0 + kk) * ldw + n0 + (lane & 31)] * 32.f; }
    LDS_WAIT(); asm volatile("" ::: "memory");
    const int c = lane & 3;
#pragma unroll
    for (int j = 0; j < 2; ++j) { const int n = (lane >> 2) + 16 * j; const LAS float* s = scr + (16 * c) * 33 + n;
        u32x4 o; o.x = pk4_fp8(s[0 * 33], s[1 * 33], s[2 * 33], s[3 * 33]); o.y = pk4_fp8(s[4 * 33], s[5 * 33], s[6 * 33], s[7 * 33]);
        o.z = pk4_fp8(s[8 * 33], s[9 * 33], s[10 * 33], s[11 * 33]); o.w = pk4_fp8(s[12 * 33], s[13 * 33], s[14 * 33], s[15 * 33]);
        *(GAS u32x4*)(WT + (drow0 + n) * (size_t)ldd + dcol0 + 16 * c) = o; }
    LDS_WAIT(); asm volatile("" ::: "memory");
}
__device__ __forceinline__ void p0_prologue(const Params& P, Frame& F) {
    LAS float* scr = (LAS float*)(F.lds + F.wave * 16384);
    const int gw = F.vcu * NWAVES + F.wave, NGW = F.G * NWAVES, lane = F.lane;
    unsigned char* ws = P.ws;
    constexpr int T_MOD = 768, T_WF = 512, T_ROPE = 256, T_WR = 768, I_WIN = 1024, I_WOUT = 256;
    constexpr int NITEMS = T_MOD + T_WF + T_ROPE + T_WR + I_WIN + I_WOUT;
    for (int it = gw; it < NITEMS; it += NGW) {
        int r = it;
        if (r < T_MOD) {
            const int nc = r >> 3, kq = r & 7, n0 = nc * 64;
            for (int idx = lane; idx < 2048; idx += 64) { const int b = idx & 15, kk = idx >> 4; const float v = P.c[b * DM + kq * 128 + kk]; scr[kk * 16 + b] = v / (1.f + __expf(-v)); }
            LDS_WAIT(); asm volatile("" ::: "memory");
            float acc[16];
#pragma unroll
            for (int b = 0; b < 16; ++b) acc[b] = 0.f;
            const float* wp = P.w_ada + (size_t)(kq * 128) * 6144 + n0 + lane;
#pragma unroll 8
            for (int kk = 0; kk < 128; ++kk) { const float w = wp[(size_t)kk * 6144];
#pragma unroll
                for (int b4 = 0; b4 < 4; ++b4) { const f32x4 s = *(const LAS f32x4*)(scr + kk * 16 + b4 * 4); acc[b4 * 4 + 0] += w * s[0]; acc[b4 * 4 + 1] += w * s[1]; acc[b4 * 4 + 2] += w * s[2]; acc[b4 * 4 + 3] += w * s[3]; } }
            float* mp = (float*)(ws + WS_MODP) + (size_t)(kq * 16) * 6144 + n0 + lane;
#pragma unroll
            for (int b = 0; b < 16; ++b) mp[(size_t)b * 6144] = acc[b];
            LDS_WAIT(); asm volatile("" ::: "memory");
            continue; }
        r -= T_MOD;
        if (r < T_WF) {
            const int g = r >> 7, cc = (r >> 4) & 7, nc = r & 15, c0 = cc * 16, n0 = nc * 64;
            for (int idx = lane; idx < 2048; idx += 64) { const int d = idx & 127, c = idx >> 7; scr[d * 16 + c] = P.w_pool[(size_t)(g * 128 + c0 + c) * 128 + d] * P.pool_scale[g * 128 + d]; }
            LDS_WAIT(); asm volatile("" ::: "memory");
            float acc[16];
#pragma unroll
            for (int c = 0; c < 16; ++c) acc[c] = 0.f;
            const float* wp = P.w_out + (size_t)(512 + g * 128) * DM + n0 + lane;
#pragma unroll 8
            for (int d = 0; d < 128; ++d) { const float w = wp[(size_t)d * DM];
#pragma unroll
                for (int c4 = 0; c4 < 4; ++c4) { const f32x4 s = *(const LAS f32x4*)(scr + d * 16 + c4 * 4); acc[c4 * 4 + 0] += w * s[0]; acc[c4 * 4 + 1] += w * s[1]; acc[c4 * 4 + 2] += w * s[2]; acc[c4 * 4 + 3] += w * s[3]; } }
            bf16_t* dst = (bf16_t*)(ws + WS_WMIX) + (size_t)(n0 + lane) * DM + 512 + g * 128 + c0;
            u32x4 o0, o1; o0.x = pk2(acc[0], acc[1]); o0.y = pk2(acc[2], acc[3]); o0.z = pk2(acc[4], acc[5]); o0.w = pk2(acc[6], acc[7]);
            o1.x = pk2(acc[8], acc[9]); o1.y = pk2(acc[10], acc[11]); o1.z = pk2(acc[12], acc[13]); o1.w = pk2(acc[14], acc[15]);
            *(GAS u32x4*)dst = o0; *(GAS u32x4*)(dst + 8) = o1;
            LDS_WAIT(); asm volatile("" ::: "memory");
            continue; }
        r -= T_WF;
        if (r < T_ROPE) {
            const int idx = r * 64 + lane, pos = idx >> 3, j = idx & 7;
            const float invf = (float)exp(-(double)j * 1.640295422175541);
            const float ang = (float)pos * invf;
            const double rev = (double)ang * 0.15915494309189535; const float fr = (float)(rev - floor(rev));
            float* rp = (float*)(ws + WS_ROPE) + (size_t)pos * 16;
            rp[j] = __builtin_amdgcn_cosf(fr); rp[8 + j] = __builtin_amdgcn_sinf(fr);
            continue; }
        r -= T_ROPE;
        if (r < T_WR) {
            const int n = r >> 4, k = (r & 15) * 64 + lane;
            const float v = n < 4 ? P.w_rg[k * 4 + n] : (n < 36 ? P.w_re[k * 32 + (n - 4)] : 0.f);
            const unsigned hb = f2bf(v); const float lo = v - bf2f((unsigned short)hb);
            ((bf16_t*)(ws + WS_WRHI))[n * DM + k] = (bf16_t)hb; ((bf16_t*)(ws + WS_WRLO))[n * DM + k] = (bf16_t)f2bf(lo);
            continue; }
        r -= T_WR;
        if (r < I_WIN) { const int kb = r >> 6, nb = r & 63; transpose_item(P.w_in, 2048, kb * 64, nb * 32, (bf16_t*)(ws + WS_WIN), (size_t)nb * 32, DM, kb * 64, scr, lane); continue; }
        r -= I_WIN;
        { const int kb = r >> 5, nb = r & 31; transpose_item(P.w_out, DM, kb * 64, nb * 32, (bf16_t*)(ws + WS_WMIX), (size_t)nb * 32, DM, kb * 64, scr, lane); }
    }
}
__device__ __forceinline__ void p1_norm1(const Params& P, Frame& F) {
    const int gw = F.vcu * NWAVES + F.wave, NGW = F.G * NWAVES, lane = F.lane;
    unsigned char* ws = P.ws;
    const float* modp = (const float*)(ws + WS_MODP);
    for (int t = gw; t < 1536; t += NGW) {
        const int idx = t * 64 + lane, b = idx / 6144, n = idx - b * 6144;
        float v = P.b_ada[n];
#pragma unroll
        for (int kq = 0; kq < 8; ++kq) v += modp[(size_t)(kq * 16 + b) * 6144 + n];
        ((float*)(ws + WS_MODF))[idx] = v;
        if ((n >> 10) == 4) ((float*)(ws + WS_GM2))[b * DM + (n & 1023)] = P.norm2_g[n & 1023] * (1.f + v);
    }
    bf16_t* H1 = (bf16_t*)(ws + WS_H1);
    for (int g16 = gw; g16 < NTOK / 16; g16 += NGW) {
        const int row0 = g16 * 16, b = row0 >> 11;
        f32x4 gm[4], sh[4];
#pragma unroll
        for (int j = 0; j < 4; ++j) { const int col = 4 * lane + 256 * j;
            f32x4 s0 = *(const f32x4*)(P.b_ada + col), s1 = *(const f32x4*)(P.b_ada + 1024 + col);
#pragma unroll
            for (int kq = 0; kq < 8; ++kq) { const float* mp = modp + (size_t)(kq * 16 + b) * 6144 + col; s0 += *(const f32x4*)mp; s1 += *(const f32x4*)(mp + 1024); }
            sh[j] = s0; gm[j] = *(const f32x4*)(P.norm1_g + col) * (1.f + s1); }
        for (int rr = 0; rr < 16; ++rr) {
            const int row = row0 + rr;
            const GAS f32x4* xr = (const GAS f32x4*)(P.x + (size_t)row * DM) + lane;
            f32x4 v[4]; float s = 0.f;
#pragma unroll
            for (int j = 0; j < 4; ++j) { v[j] = xr[64 * j]; s += (v[j].x * v[j].x + v[j].y * v[j].y) + (v[j].z * v[j].z + v[j].w * v[j].w); }
            const float rstd = __builtin_amdgcn_rsqf(wave_sum(s) * (1.f / DM) + RMS_EPS);
            GAS u32x2* o8 = (GAS u32x2*)(H1 + (size_t)row * DM) + lane;
#pragma unroll
            for (int j = 0; j < 4; ++j) { const f32x4 hh = v[j] * rstd * gm[j] + sh[j]; u32x2 w; w.x = cvt_pk_bf16(hh.x, hh.y); w.y = cvt_pk_bf16(hh.z, hh.w); st8_wt((void*)(o8 + 64 * j), w); }
        }
    }
}
__device__ __forceinline__ void p3_pooldiff(const Params& P, Frame& F) {
    const int gw = F.vcu * NWAVES + F.wave, NGW = F.G * NWAVES, lane = F.lane;
    const bf16_t* U = (const bf16_t*)(P.ws + WS_U); bf16_t* MIX = (bf16_t*)(P.ws + WS_MIXIN);
    const int g = lane >> 4, left = 1 << g, right = (1 << g) - 1;
    for (int t = gw; t < NTOK / 16; t += NGW) {
        const int row0 = t * 16, b = row0 >> 11, p0 = row0 & (SEQ - 1);
        const bf16_t* ub = U + (size_t)b * SEQ * 512 + lane * 8;
        float sum[8];
#pragma unroll
        for (int j = 0; j < 8; ++j) sum[j] = 0.f;
        { bf16x8 wv_[16];
#pragma unroll
          for (int q = 0; q < 16; ++q) { const int dj = q - 8, pj = p0 + dj; const bool in = dj >= -left && dj <= right && pj >= 0 && pj < SEQ;
              wv_[q] = in ? *(const bf16x8*)(ub + (size_t)pj * 512) : (bf16x8){0, 0, 0, 0, 0, 0, 0, 0}; }
#pragma unroll
          for (int q = 0; q < 16; ++q)
#pragma unroll
              for (int j = 0; j < 8; ++j) sum[j] += bf2f((unsigned short)wv_[q][j]); }
#pragma unroll
        for (int hb_ = 0; hb_ < 2; ++hb_) {
            bf16x8 cv[8], av[8], sv[8];
#pragma unroll
            for (int q = 0; q < 8; ++q) { const int p = p0 + hb_ * 8 + q, pa = p + 1 + right, ps = p - left;
                cv[q] = *(const bf16x8*)(ub + (size_t)p * 512);
                av[q] = pa < SEQ ? *(const bf16x8*)(ub + (size_t)pa * 512) : (bf16x8){0, 0, 0, 0, 0, 0, 0, 0};
                sv[q] = ps >= 0 ? *(const bf16x8*)(ub + (size_t)ps * 512) : (bf16x8){0, 0, 0, 0, 0, 0, 0, 0}; }
#pragma unroll
            for (int q = 0; q < 8; ++q) { const int p = p0 + hb_ * 8 + q;
                const int lo = p - left < 0 ? 0 : p - left, hi = p + right + 1 > SEQ ? SEQ : p + right + 1;
                const float inv = 1.f / (float)(hi - lo);
                float d[8];
#pragma unroll
                for (int j = 0; j < 8; ++j) d[j] = sum[j] * inv - bf2f((unsigned short)cv[q][j]);
                u32x4 w; w.x = cvt_pk_bf16(d[0], d[1]); w.y = cvt_pk_bf16(d[2], d[3]); w.z = cvt_pk_bf16(d[4], d[5]); w.w = cvt_pk_bf16(d[6], d[7]);
                *(u32x4*)(MIX + (size_t)(b * SEQ + p) * DM + 512 + lane * 8) = w;
#pragma unroll
                for (int j = 0; j < 8; ++j) sum[j] += bf2f((unsigned short)av[q][j]) - bf2f((unsigned short)sv[q][j]); }
        }
    }
}
#define ADD_DELTA(A, C, Dq) do { (A).x += __builtin_bit_cast(float, (Dq).x << 16); (A).y += __builtin_bit_cast(float, (Dq).x & 0xffff0000u); (A).z += __builtin_bit_cast(float, (Dq).y << 16); (A).w += __builtin_bit_cast(float, (Dq).y & 0xffff0000u); \
    (C).x += __builtin_bit_cast(float, (Dq).z << 16); (C).y += __builtin_bit_cast(float, (Dq).z & 0xffff0000u); (C).z += __builtin_bit_cast(float, (Dq).w << 16); (C).w += __builtin_bit_cast(float, (Dq).w & 0xffff0000u); } while (0)
__device__ __forceinline__ void p5_norm2_route(const Params& P, Frame& F, const int reps) {
    const int lane = F.lane, rr = lane & 15, kq = lane >> 4, kw = F.wave;
    unsigned char* ws = P.ws;
    LAS float* L_GM = (LAS float*)(F.lds); LAS float* L_SH = (LAS float*)(F.lds + 4096);
    LAS float* ssqp = (LAS float*)(F.lds + 8192);
    LAS float* L_BI = (LAS float*)(F.lds + 8192 + 1024);
    LAS float* lgp = (LAS float*)(F.lds + 12288);
    LAS int* rres = (LAS int*)(F.lds + 36864);
    LAS int* hist = (LAS int*)(F.lds + TB_HIST); LAS int* hb = (LAS int*)(F.lds + TB_HB);
    const float* gm2 = (const float*)(ws + WS_GM2); const float* modf = (const float*)(ws + WS_MODF);
    const bf16_t* wrhi = (const bf16_t*)(ws + WS_WRHI); const bf16_t* wrlo = (const bf16_t*)(ws + WS_WRLO);
    unsigned char* H2 = ws + WS_H2;
    int* rinfo = (int*)(ws + WS_RINFO); float* rw = (float*)(ws + WS_RW);
    gu32* cnt = (gu32*)(ws + WS_CTL) + CW_CNT;
    const int colb = kw * 128 + kq * 8;
    bf16x8 bhi[4][3], blo[4][3];
#pragma unroll
    for (int ks = 0; ks < 4; ++ks)
#pragma unroll
        for (int nb = 0; nb < 3; ++nb) { bhi[ks][nb] = *(const bf16x8*)(wrhi + (size_t)(nb * 16 + rr) * DM + colb + ks * 32); blo[ks][nb] = *(const bf16x8*)(wrlo + (size_t)(nb * 16 + rr) * DM + colb + ks * 32); }
    for (int rp_ = 0; rp_ < reps; ++rp_) { const bool dry = rp_ + 1 < reps;
    for (int blk = F.vcu; blk < NTOK / 128; blk += F.G) {
        const int b = (blk * 128) >> 11;
        if (F.tid < 256) { *(LAS f32x4*)(L_GM + 4 * F.tid) = *(const f32x4*)(gm2 + (size_t)b * DM + 4 * F.tid); *(LAS f32x4*)(L_SH + 4 * F.tid) = *(const f32x4*)(modf + (size_t)b * 6144 + 3 * 1024 + 4 * F.tid); }
        if (F.tid < 32) hist[F.tid] = 0;
        if (F.tid >= 64 && F.tid < 100) L_BI[F.tid - 64] = (F.tid < 68) ? P.b_rg[F.tid - 64] : P.b_re[F.tid - 68];
        const float* xbase = P.x + (size_t)(blk * 128 + rr) * DM + colb;
        const bf16_t* dbase = (const bf16_t*)(ws + WS_DELTA) + (size_t)(blk * 128 + rr) * DM + colb;
        f32x4 xa[4], xc[4]; u32x4 dl[4];
#pragma unroll
        for (int ks = 0; ks < 4; ++ks) { xa[ks] = *(const f32x4*)(xbase + ks * 32); xc[ks] = *(const f32x4*)(xbase + ks * 32 + 4); dl[ks] = *(const u32x4*)(dbase + ks * 32); }
        __syncthreads();
        for (int it = 0; it < 8; ++it) {
            const int row0 = blk * 128 + it * 16;
            float ssq = 0.f;
#pragma unroll
            for (int ks = 0; ks < 4; ++ks) { ADD_DELTA(xa[ks], xc[ks], dl[ks]); const f32x4 a = xa[ks], c = xc[ks]; ssq += (a.x * a.x + a.y * a.y) + (a.z * a.z + a.w * a.w) + (c.x * c.x + c.y * c.y) + (c.z * c.z + c.w * c.w); }
            ssq += __shfl_xor(ssq, 16); ssq += __shfl_xor(ssq, 32);
            if (kq == 0) ssqp[kw * 16 + rr] = ssq;
            __syncthreads();
            float tot = 0.f;
#pragma unroll
            for (int w = 0; w < 8; ++w) tot += ssqp[w * 16 + rr];
            const float rstd = __builtin_amdgcn_rsqf(tot * (1.f / DM) + RMS_EPS);
            f32x4 acc[3] = {{0.f, 0.f, 0.f, 0.f}, {0.f, 0.f, 0.f, 0.f}, {0.f, 0.f, 0.f, 0.f}};
            unsigned char* hrow = H2 + (size_t)(row0 + rr) * DM + colb;
            const float* xnext = xbase + (size_t)(it + 1) * 16 * DM; const bf16_t* dnext = dbase + (size_t)(it + 1) * 16 * DM;
#pragma unroll
            for (int ks = 0; ks < 4; ++ks) {
                const f32x4 g0 = *(const LAS f32x4*)(L_GM + colb + ks * 32), g1 = *(const LAS f32x4*)(L_GM + colb + ks * 32 + 4);
                const f32x4 s0 = *(const LAS f32x4*)(L_SH + colb + ks * 32), s1 = *(const LAS f32x4*)(L_SH + colb + ks * 32 + 4);
                const f32x4 h0 = xa[ks] * rstd * g0 + s0, h1 = xc[ks] * rstd * g1 + s1;
                if (it < 7) { xa[ks] = *(const f32x4*)(xnext + ks * 32); xc[ks] = *(const f32x4*)(xnext + ks * 32 + 4); dl[ks] = *(const u32x4*)(dnext + ks * 32); }
                u32x4 whi; whi.x = cvt_pk_bf16(h0.x, h0.y); whi.y = cvt_pk_bf16(h0.z, h0.w); whi.z = cvt_pk_bf16(h1.x, h1.y); whi.w = cvt_pk_bf16(h1.z, h1.w);
                f32x4 l0, l1;
                l0.x = h0.x - __builtin_bit_cast(float, whi.x << 16); l0.y = h0.y - __builtin_bit_cast(float, whi.x & 0xffff0000u);
                l0.z = h0.z - __builtin_bit_cast(float, whi.y << 16); l0.w = h0.w - __builtin_bit_cast(float, whi.y & 0xffff0000u);
                l1.x = h1.x - __builtin_bit_cast(float, whi.z << 16); l1.y = h1.y - __builtin_bit_cast(float, whi.z & 0xffff0000u);
                l1.z = h1.z - __builtin_bit_cast(float, whi.w << 16); l1.w = h1.w - __builtin_bit_cast(float, whi.w & 0xffff0000u);
                u32x4 wlo; wlo.x = cvt_pk_bf16(l0.x, l0.y); wlo.y = cvt_pk_bf16(l0.z, l0.w); wlo.z = cvt_pk_bf16(l1.x, l1.y); wlo.w = cvt_pk_bf16(l1.z, l1.w);
                { u32x2 w8; w8.x = pk4_fp8(h0.x, h0.y, h0.z, h0.w); w8.y = pk4_fp8(h1.x, h1.y, h1.z, h1.w); st8_wt(hrow + ks * 32, w8); }
                const bf16x8 ahi = __builtin_bit_cast(bf16x8, whi), alo = __builtin_bit_cast(bf16x8, wlo);
#pragma unroll
                for (int nb = 0; nb < 3; ++nb) {
                    acc[nb] = __builtin_amdgcn_mfma_f32_16x16x32_bf16(ahi, bhi[ks][nb], acc[nb], 0, 0, 0);
                    acc[nb] = __builtin_amdgcn_mfma_f32_16x16x32_bf16(alo, bhi[ks][nb], acc[nb], 0, 0, 0);
                    acc[nb] = __builtin_amdgcn_mfma_f32_16x16x32_bf16(ahi, blo[ks][nb], acc[nb], 0, 0, 0);
                }
            }
            LAS float* lgw = lgp + kw * 768;
#pragma unroll
            for (int nb = 0; nb < 3; ++nb)
#pragma unroll
                for (int r = 0; r < 4; ++r) lgw[(kq * 4 + r) * 48 + nb * 16 + rr] = acc[nb][r];
            __syncthreads();
            if (kw == it && lane < 16) {
                const LAS float* L = lgp + lane * 48;
#define LG(j) (((L[(j)] + L[768 + (j)]) + (L[1536 + (j)] + L[2304 + (j)])) + ((L[3072 + (j)] + L[3840 + (j)]) + (L[4608 + (j)] + L[5376 + (j)])))
                float gl[4]; int gs = 0; float gmx;
#pragma unroll
                for (int j = 0; j < 4; ++j) gl[j] = LG(j) + L_BI[j];
                gmx = gl[0];
#pragma unroll
                for (int j = 1; j < 4; ++j) if (gl[j] > gmx) { gmx = gl[j]; gs = j; }
                float gden = 0.f;
#pragma unroll
                for (int j = 0; j < 4; ++j) gden += __expf(gl[j] - gmx);
                const float gpv = 1.f / gden;
                float el[8];
#pragma unroll
                for (int j = 0; j < 8; ++j) el[j] = LG(4 + gs * 8 + j) + L_BI[4 + gs * 8 + j];
#undef LG
                int i0 = 0; float m0 = el[0];
#pragma unroll
                for (int j = 1; j < 8; ++j) if (el[j] > m0) { m0 = el[j]; i0 = j; }
                int i1 = -1; float m1 = -3.0e38f;
#pragma unroll
                for (int j = 0; j < 8; ++j) if (j != i0 && el[j] > m1) { m1 = el[j]; i1 = j; }
                const float tt = __expf(m1 - m0), den = 1.f / (1.f + tt);
                const int e0 = gs * 8 + i0, e1 = gs * 8 + i1;
                int lr0 = 0, lr1 = 0;
                if (!dry) { lr0 = atomicAdd((int*)(hist + e0), 1); lr1 = atomicAdd((int*)(hist + e1), 1); }
                LAS int* rp = rres + (it * 16 + lane) * 6;
                rp[0] = e0; rp[1] = e1; rp[2] = __builtin_bit_cast(int, gpv * den); rp[3] = __builtin_bit_cast(int, gpv * tt * den); rp[4] = lr0; rp[5] = lr1;
            }
        }
        __syncthreads();
        if (F.tid < 32 && !dry) { const int hc = hist[F.tid]; hb[F.tid] = hc ? (int)__hip_atomic_fetch_add(cnt + 64 * F.tid, (unsigned)hc, __ATOMIC_RELAXED, __HIP_MEMORY_SCOPE_AGENT) : 0; }
        __syncthreads();
        if (F.tid < 128 && !dry) { const LAS int* rp = rres + F.tid * 6; const int tok = blk * 128 + F.tid;
            const int e0 = rp[0], e1 = rp[1];
            const int p0 = e0 * ECAP + hb[e0] + rp[4], p1 = e1 * ECAP + hb[e1] + rp[5];
            rinfo[p0] = tok * 2; rw[p0] = __builtin_bit_cast(float, rp[2]); rinfo[p1] = tok * 2 + 1; rw[p1] = __builtin_bit_cast(float, rp[3]); }
        __syncthreads();
    }
    }
}
__device__ __forceinline__ int p6_tables(const Params& P, Frame& F) {
    LAS int* rt_e = (LAS int*)(F.lds + TB_RTE); LAS int* rtb = (LAS int*)(F.lds + TB_RTB); LAS int* cs = (LAS int*)(F.lds + TB_CNT);
    gu32* cnt = (gu32*)(P.ws + WS_CTL) + CW_CNT;
    if (F.tid < 32) cs[F.tid] = (int)__hip_atomic_load(cnt + 64 * F.tid, __ATOMIC_RELAXED, __HIP_MEMORY_SCOPE_AGENT);
    __syncthreads();
    if (F.tid == 0) { int a = 0; for (int e = 0; e < NEXP; ++e) { rtb[e] = a; a += (cs[e] + 255) >> 8; } rtb[NEXP] = a; }
    __syncthreads();
    const int nrt = rtb[NEXP];
    if (F.tid < nrt && F.tid < 320) { int e = 0; for (int j = 1; j < NEXP; ++j) e += (rtb[j] <= F.tid) ? 1 : 0; rt_e[F.tid] = e; }
    __syncthreads();
    return nrt;
}
__device__ __forceinline__ void p6_rowlists(const Params& P, Frame& F, const gm::MoeOrder& S) {
    LAS int* tokrow = (LAS int*)(F.lds + TB_TOK); LAS float* wrow = (LAS float*)(F.lds + TB_W); LAS int* cs = (LAS int*)(F.lds + TB_CNT);
    const int* rinfo = (const int*)(P.ws + WS_RINFO); const float* rw = (const float*)(P.ws + WS_RW);
    if (F.tid < 256) {
        int ti[MAXU]; float tw[MAXU]; bool have[MAXU];
#pragma unroll
        for (int li = 0; li < MAXU; ++li) { gm::Unit u; have[li] = S.next(li, u); ti[li] = -1; tw[li] = 0.f;
            if (have[li]) { const int idx = u.mt * 256 + F.tid; if (idx < cs[u.e]) { ti[li] = rinfo[(size_t)u.e * ECAP + idx]; tw[li] = rw[(size_t)u.e * ECAP + idx]; } } }
#pragma unroll
        for (int li = 0; li < MAXU; ++li) if (have[li]) { tokrow[li * 256 + F.tid] = ti[li]; wrow[li * 256 + F.tid] = tw[li]; }
    }
    __syncthreads();
}
__device__ __forceinline__ void p8_final(const Params& P, Frame& F, float* dst) {
    const int gw = F.vcu * NWAVES + F.wave, NGW = F.G * NWAVES, lane = F.lane;
    const unsigned char* YS = P.ws + WS_YS; const float* modf = (const float*)(P.ws + WS_MODF);
    f32x4 fg[4];
#pragma unroll
    for (int j = 0; j < 4; ++j) fg[j] = *(const f32x4*)(P.final_g + 4 * lane + 256 * j);
    for (int g16 = gw; g16 < NTOK / 16; g16 += NGW) {
        const int row0 = g16 * 16, b = row0 >> 11;
        f32x4 g2[4];
#pragma unroll
        for (int j = 0; j < 4; ++j) g2[j] = *(const f32x4*)(modf + (size_t)b * 6144 + 5 * 1024 + 4 * lane + 256 * j);
        for (int rr = 0; rr < 16; ++rr) {
            const int row = row0 + rr;
            const GAS f32x4* xr = (const GAS f32x4*)(P.x + (size_t)row * DM) + lane; const GAS u32x2* dr = (const GAS u32x2*)((const bf16_t*)(P.ws + WS_DELTA) + (size_t)row * DM) + lane;
            const GAS unsigned* ya = (const GAS unsigned*)(YS + (size_t)(2 * row) * DM) + lane; const GAS unsigned* yb = (const GAS unsigned*)(YS + (size_t)(2 * row + 1) * DM) + lane;
            f32x4 v[4]; float s = 0.f;
#pragma unroll
            for (int j = 0; j < 4; ++j) { f32x4 xv = xr[64 * j]; const u32x2 dq = dr[64 * j]; const unsigned a = ya[64 * j], c = yb[64 * j];
                xv.x += __builtin_bit_cast(float, dq.x << 16); xv.y += __builtin_bit_cast(float, dq.x & 0xffff0000u); xv.z += __builtin_bit_cast(float, dq.y << 16); xv.w += __builtin_bit_cast(float, dq.y & 0xffff0000u);
                const f32x2 a0 = __builtin_amdgcn_cvt_pk_f32_fp8((int)a, false), a1 = __builtin_amdgcn_cvt_pk_f32_fp8((int)a, true), c0 = __builtin_amdgcn_cvt_pk_f32_fp8((int)c, false), c1 = __builtin_amdgcn_cvt_pk_f32_fp8((int)c, true);
                f32x4 y; y.x = a0.x + c0.x; y.y = a0.y + c0.y; y.z = a1.x + c1.x; y.w = a1.y + c1.y;
                v[j] = xv + g2[j] * (y * 0.0625f); s += (v[j].x * v[j].x + v[j].y * v[j].y) + (v[j].z * v[j].z + v[j].w * v[j].w); }
            const float rstd = __builtin_amdgcn_rsqf(wave_sum(s) * (1.f / DM) + RMS_EPS);
#pragma unroll
            for (int j = 0; j < 4; ++j) ((GAS f32x4*)(dst + (size_t)row * DM) + lane)[64 * j] = v[j] * rstd * fg[j];
        }
    }
}

__device__ __forceinline__ void ph2_inproj(const Params& P, Frame& F) {
    unsigned char* ws = P.ws;
    gm::DenseOrder S; S.init(ws + WS_H1, ws + WS_WIN, NTOK, 2048, DM, F.G, (int)blockIdx.x);
    gm::EpiQKVU E{(bf16_t*)(ws + WS_Q), (bf16_t*)(ws + WS_K), (bf16_t*)(ws + WS_V), (bf16_t*)(ws + WS_U), (const float*)(ws + WS_ROPE)};
    gm::gemm_phase<gm::EpiQKVU, gm::DenseOrder>(F.lds, S, E);
}
__device__ __forceinline__ void ph3_mixers(const Params& P, Frame& F, char* lds_gen, const int reps) {
    unsigned char* ws = P.ws;
    p3_pooldiff(P, F);
    const float lam = __expf(wave_sum(P.lq1[F.lane] * P.lk1[F.lane])) - __expf(wave_sum(P.lq2[F.lane] * P.lk2[F.lane])) + 0.2f;
    att::Weave wv{P.w_gate, P.w_up, P.w_down, ws + WS_WGU, ws + WS_WD, 0, 0, -1};
    { const int per = (6144 + F.G - 1) / F.G; wv.next = F.vcu * per; wv.end = wv.next + per < 6144 ? wv.next + per : 6144; if (wv.next > 6144) wv.next = 6144; }
    const int rounds = (NB * 4 * 16 + F.G - 1) / F.G;
    for (int ii = 0; ii < reps * rounds; ++ii) {
        const int i = ii % rounds;
        const int U = i * F.G + F.vcu; if (U >= NB * 4 * 16) continue;
        const int bh = U >> 4, qb = U & 15;
        att::attn_unit((const bf16_t*)(ws + WS_Q), (const bf16_t*)(ws + WS_K), (const bf16_t*)(ws + WS_V), (bf16_t*)(ws + WS_MIXIN), bh >> 2, bh & 3, qb, lam, P.subln_g, lds_gen, F.lds, wv);
    }
    while (wv.pend >= 0 || wv.next < wv.end) { asm volatile("s_waitcnt vmcnt(0)" ::: "memory"); att::weave_step(wv, lds_gen, F.lds, F.wave, F.lane); }
}
__device__ __forceinline__ void ph4_outproj(const Params& P, Frame& F) {
    unsigned char* ws = P.ws;
    gm::DenseOrder S; S.init(ws + WS_MIXIN, ws + WS_WMIX, NTOK, DM, DM, F.G, (int)blockIdx.x);
    gm::EpiMix E{(bf16_t*)(ws + WS_DELTA), (const float*)(ws + WS_MODF) + 2 * 1024};
    gm::gemm_phase<gm::EpiMix, gm::DenseOrder>(F.lds, S, E);
}
__device__ __forceinline__ void ph6_gateup(const Params& P, Frame& F, gm::MoeOrder S) {
    unsigned char* ws = P.ws;
    S.KB = DM; S.A = (const char*)(ws + WS_H2); S.Bt = (const char*)(ws + WS_WGU); S.bexp = (size_t)DM * DM; S.gather = true;
    gm::EpiGateUp E{ws + WS_HID};
    gm::gemm_phase<gm::EpiGateUp, gm::MoeOrder, true>(F.lds, S, E);
}
__device__ __forceinline__ void ph7_down(const Params& P, Frame& F, gm::MoeOrder S) {
    unsigned char* ws = P.ws;
    S.KB = DEXP; S.A = (const char*)(ws + WS_HID); S.Bt = (const char*)(ws + WS_WD); S.bexp = (size_t)DM * DEXP; S.gather = false;
    gm::EpiDown E{ws + WS_YS, (const LAS int*)(F.lds + TB_TOK), (const LAS float*)(F.lds + TB_W)};
    gm::gemm_phase<gm::EpiDown, gm::MoeOrder, true>(F.lds, S, E);
}

__global__ void __launch_bounds__(NTHR, 2) fwd_kernel(Params P) {
    extern __shared__ __attribute__((aligned(16))) unsigned char lds_raw[];
    Frame F;
    F.lds = (LAS unsigned char*)lds_raw;
    F.tid = threadIdx.x; F.lane = F.tid & 63; F.wave = __builtin_amdgcn_readfirstlane(F.tid >> 6);
    F.G = gridDim.x; { const int bx = blockIdx.x; F.vcu = (F.G % 8 == 0) ? (bx % 8) * (F.G / 8) + bx / 8 : bx; }
    unsigned char* ws = P.ws;
    gu32* ctl = (gu32*)(ws + WS_CTL);
    volatile LAS unsigned* MISC = (volatile LAS unsigned*)(F.lds + MISC_OFF);
    for (int u = F.tid; u < (LDS_BYTES - RING_BYTES) / 4; u += NTHR) ((LAS unsigned*)(F.lds + RING_BYTES))[u] = 0u;
    __syncthreads();
    const int lo = (int)(P.ph & 0xff), hi = (int)((P.ph >> 8) & 0xff), li = (int)((P.ph >> 16) & 0xff);
    XcdBarrier bar; bar.bar = (unsigned*)(ctl + CW_BAR) + li * XCD_BAR_WORDS; bar.x = 0; bar.st = nullptr;
    if (N_LAUNCHES != N_PHASES) bar = xcd_barrier_post((unsigned*)(ctl + CW_BAR) + li * XCD_BAR_WORDS, MISC + 8);
#define IN(k) (lo <= (k) && (k) < hi)
#define GRID_BAR(k) do { if (IN(k) && IN((k) + 1)) xcd_barrier(bar); } while (0)
#define RUN(k, call) do { if (IN(k)) { { constexpr int rep = 0; (void)rep; call; } if (PROBE_PHASE == (k)) { xcd_barrier(bar); { constexpr int rep = 1; (void)rep; call; } } GRID_BAR(k); } } while (0)

    RUN(0, p0_prologue(P, F));
    RUN(1, p1_norm1(P, F));
    RUN(2, ph2_inproj(P, F));
    if (IN(3)) { ph3_mixers(P, F, (char*)lds_raw, PROBE_PHASE == 3 ? 2 : 1); GRID_BAR(3); }
    RUN(4, ph4_outproj(P, F));
    if (IN(5)) { p5_norm2_route(P, F, PROBE_PHASE == 5 ? 2 : 1); GRID_BAR(5); }
    if (IN(6) || IN(7)) {
        const int nrt = p6_tables(P, F);
        gm::MoeOrder S; S.rt_e = (const LAS int*)(F.lds + TB_RTE); S.rtbase = (const LAS int*)(F.lds + TB_RTB); S.tokrow = (const LAS int*)(F.lds + TB_TOK);
        S.nunits = 4 * nrt; S.G = F.G; S.c = (int)blockIdx.x; S.KB = 0; S.A = nullptr; S.Bt = nullptr; S.bexp = 0; S.gather = false;
        p6_rowlists(P, F, S);
        RUN(6, ph6_gateup(P, F, S));
        RUN(7, ph7_down(P, F, S));
    }
    RUN(8, p8_final(P, F, (rep == 0 && PROBE_PHASE == 8) ? (float*)(ws + WS_A) : P.out));
#undef IN
#undef GRID_BAR
#undef RUN
}

extern "C" void kernel_launch(void* const* d_in, const int* in_sizes, int n_in, void* d_out, int out_size, void* d_ws, size_t ws_size, hipStream_t stream) {
    static int grid = 0;
    if (grid == 0) {
        if (n_in != 23 || in_sizes[0] != NTOK * DM || out_size != NTOK * DM || ws_size < WS_END) { fprintf(stderr, "kernel_launch: unexpected shapes (n_in %d, in0 %d, out %d, ws %zu)\n", n_in, n_in > 0 ? in_sizes[0] : -1, out_size, ws_size); grid = -1; return; }
        int dev = 0, cus = 0, per_cu = 0;
        if (hipGetDevice(&dev) != hipSuccess || hipDeviceGetAttribute(&cus, hipDeviceAttributeMultiprocessorCount, dev) != hipSuccess) { grid = -1; return; }
        if (hipFuncSetAttribute((const void*)fwd_kernel, hipFuncAttributeMaxDynamicSharedMemorySize, LDS_BYTES) != hipSuccess) { fprintf(stderr, "kernel_launch: hipFuncSetAttribute failed\n"); grid = -1; return; }
        if (hipOccupancyMaxActiveBlocksPerMultiprocessor(&per_cu, (const void*)fwd_kernel, NTHR, LDS_BYTES) != hipSuccess || per_cu < 1) fprintf(stderr, "kernel_launch: occupancy query reports %d\n", per_cu);
        (void)hipGetLastError();
        grid = cus;
    }
    if (grid < 0) return;
    if (hipMemsetAsync((char*)d_ws + WS_CTL, 0, CTL_ZERO_BYTES, stream) != hipSuccess) return;
    Params p{};
    const float** pp = (const float**)&p;
    for (int i = 0; i < 23; ++i) pp[i] = (const float*)d_in[i];
    p.out = (float*)d_out; p.ws = (unsigned char*)d_ws;
    if (N_LAUNCHES == 1) { p.ph = 0 | ((long long)N_PHASES << 8); hipLaunchKernelGGL(fwd_kernel, dim3(grid), dim3(NTHR), LDS_BYTES, stream, p); }
    else for (int k = 0; k < N_PHASES; ++k) {
        p.ph = (long long)k | ((long long)(k + 1) << 8); hipLaunchKernelGGL(fwd_kernel, dim3(grid), dim3(NTHR), LDS_BYTES, stream, p); }
}
```

```cpp
#include <hip/hip_runtime.h>
#include <cstdio>
#include <cstdint>

#ifndef MK_N_LAUNCHES
#define MK_N_LAUNCHES 1
#endif
#ifndef PROBE_PHASE
#define PROBE_PHASE -1
#endif
constexpr int N_PHASES = 9;
constexpr int N_LAUNCHES = MK_N_LAUNCHES;

#define GAS __attribute__((address_space(1)))
#define LAS __attribute__((address_space(3)))
typedef unsigned short bf16_t;
typedef short bf16x8 __attribute__((ext_vector_type(8)));
typedef short s16x4 __attribute__((ext_vector_type(4)));
typedef float f32x2 __attribute__((ext_vector_type(2)));
typedef float f32x4 __attribute__((ext_vector_type(4)));
typedef float f32x16 __attribute__((ext_vector_type(16)));
typedef unsigned u32x2 __attribute__((ext_vector_type(2)));
typedef unsigned u32x4 __attribute__((ext_vector_type(4)));
typedef GAS unsigned gu32;
typedef int i32x8 __attribute__((ext_vector_type(8)));
typedef int i32x4 __attribute__((ext_vector_type(4)));

constexpr int DM = 1024, NB = 16, SEQ = 2048, NTOK = NB * SEQ;
constexpr int NEXP = 32, DEXP = 512, ECAP = NTOK;
constexpr int NWAVES = 8, NTHR = NWAVES * 64;
constexpr float RMS_EPS = 1e-6f;
constexpr int MAXU = 6;

constexpr size_t MiB = 1u << 20;
constexpr size_t WS_CTL = 0, CTL_ZERO_BYTES = 1 * MiB;
constexpr size_t WS_MODP = 1 * MiB;
constexpr size_t WS_MODF = 4 * MiB;
constexpr size_t WS_GM2  = WS_MODF + 384 * 1024;
constexpr size_t WS_ROPE = WS_GM2 + 64 * 1024;
constexpr size_t WS_WRHI = WS_ROPE + 128 * 1024;
constexpr size_t WS_WRLO = WS_WRHI + 96 * 1024;
constexpr size_t WS_RINFO = 5 * MiB;
constexpr size_t WS_RW    = 9 * MiB;
constexpr size_t WS_WIN  = 13 * MiB;
constexpr size_t WS_WMIX = 17 * MiB;
constexpr size_t WS_WGU  = 19 * MiB;
constexpr size_t WS_WD   = 83 * MiB;
constexpr size_t WS_A    = 115 * MiB;
constexpr size_t WS_H1   = WS_A;
constexpr size_t WS_HID  = WS_A;
constexpr size_t WS_MIXIN = WS_A + 72 * MiB;
constexpr size_t WS_H2   = WS_A + 72 * MiB;
constexpr size_t WS_Q    = 251 * MiB;
constexpr size_t WS_K    = WS_Q + 32 * MiB;
constexpr size_t WS_V    = WS_K + 32 * MiB;
constexpr size_t WS_U    = WS_V + 32 * MiB;
constexpr size_t WS_DELTA = WS_V;
constexpr size_t WS_YS   = WS_Q;
constexpr size_t WS_END  = 379 * MiB;
constexpr int CW_BAR = 4096;
constexpr int CW_CNT = 16384;

constexpr int RING_BYTES = 139264;
constexpr int TB_TOK = RING_BYTES;
constexpr int TB_W   = TB_TOK + MAXU * 1024;
constexpr int TB_RTE = TB_W + MAXU * 1024;
constexpr int TB_RTB = TB_RTE + 1280;
constexpr int TB_CNT = TB_RTB + 160;
constexpr int TB_HIST = TB_CNT + 128;
constexpr int TB_HB  = TB_HIST + 128;
constexpr int MISC_OFF = TB_HB + 128;
constexpr int LDS_BYTES = MISC_OFF + 128;
static_assert(LDS_BYTES <= 163840 && (MISC_OFF % 16) == 0, "LDS map");

#define LDS_WAIT() asm volatile("s_waitcnt lgkmcnt(0)" ::: "memory")
#define VM_WAIT() asm volatile("s_waitcnt vmcnt(0)" ::: "memory")
#define SBAR() __builtin_amdgcn_sched_barrier(0)
__device__ __forceinline__ unsigned f2bf(float f) { unsigned u = __builtin_bit_cast(unsigned, f); return (u + 0x7fffu + ((u >> 16) & 1u)) >> 16; }
__device__ __forceinline__ unsigned pk2(float lo, float hi) { return f2bf(lo) | (f2bf(hi) << 16); }
__device__ __forceinline__ float bf2f(unsigned short b) { return __builtin_bit_cast(float, (unsigned)b << 16); }
__device__ __forceinline__ unsigned cvt_pk_bf16(float lo, float hi) { unsigned r; asm volatile("v_cvt_pk_bf16_f32 %0, %1, %2" : "=v"(r) : "v"(lo), "v"(hi)); return r; }
__device__ __forceinline__ unsigned pk4_fp8(float a, float b, float c, float d) { int w = 0; w = __builtin_amdgcn_cvt_pk_fp8_f32(a, b, w, false); w = __builtin_amdgcn_cvt_pk_fp8_f32(c, d, w, true); return (unsigned)w; }
__device__ __forceinline__ float wave_sum(float v) {
#pragma unroll
    for (int o = 1; o < 64; o <<= 1) v += __shfl_xor(v, o);
    return v;
}

#define XB_TMO      128
#define XB_XCNT(j)  (256  + 64 * (j))
#define XB_XSUB(j)  (1280 + 64 * (j))
#define XB_XGEN(j)  (2304 + 64 * (j))
#define XB_TOP      3328
#define XB_TOPGEN   3392
#define XCD_BAR_WORDS 3456
#define XB_SPIN_CAP (1u << 18)
__device__ __forceinline__ unsigned xb_ld(unsigned* p)              { return __hip_atomic_load(p, __ATOMIC_RELAXED, __HIP_MEMORY_SCOPE_AGENT); }
__device__ __forceinline__ unsigned xb_add(unsigned* p, unsigned v) { return __hip_atomic_fetch_add(p, v, __ATOMIC_RELAXED, __HIP_MEMORY_SCOPE_AGENT); }
__device__ __forceinline__ unsigned xb_xcc_id() { return (unsigned)__builtin_amdgcn_s_getreg((3 << 11) | 20) & 0xFu; }
#define XB_SPIN(cond, bar) do { unsigned _sp = 0; while (cond) { __builtin_amdgcn_s_sleep(1); \
    if ((++_sp & 255u) == 0u) { if (xb_ld(&(bar)[XB_TMO])) break; if (_sp > XB_SPIN_CAP) { atomicAdd(&(bar)[XB_TMO], 1u); break; } } } } while (0)
struct XcdBarrier { unsigned* bar; unsigned x; volatile LAS unsigned* st; };
__device__ __forceinline__ XcdBarrier xcd_barrier_post(unsigned* bar, volatile LAS unsigned* st) {
    XcdBarrier b; b.bar = bar; b.x = xb_xcc_id(); b.st = st;
    if (threadIdx.x == 0) (void)xb_add(&bar[XB_XCNT(b.x)], 1u);
    return b;
}
__device__ __forceinline__ void xcd_barrier_complete(unsigned* bar, unsigned x, unsigned& nloc, unsigned& nx) {
    const unsigned G = gridDim.x * gridDim.y * gridDim.z;
    unsigned sum, cnt, mine, sp = 0u;
    for (;;) {
        sum = 0u; cnt = 0u; mine = 0u;
#pragma unroll
        for (unsigned j = 0; j < 16; ++j) { const unsigned c = xb_ld(&bar[XB_XCNT(j)]); sum += c; cnt += (c > 0u) ? 1u : 0u; mine = (j == x) ? c : mine; }
        if (sum == G) break;
        __builtin_amdgcn_s_sleep(1);
        if ((++sp & 255u) == 0u) { if (xb_ld(&bar[XB_TMO])) break; if (sp > XB_SPIN_CAP) { atomicAdd(&bar[XB_TMO], 1u); break; } }
    }
    nloc = mine > 0u ? mine : 1u; nx = cnt > 0u ? cnt : 1u;
}
__device__ __forceinline__ void xcd_barrier(const XcdBarrier& b) {
    asm volatile("s_waitcnt vmcnt(0)" ::: "memory");
    __syncthreads();
    if (threadIdx.x == 0) {
        unsigned* bar = b.bar;
        __builtin_amdgcn_s_waitcnt(0);
        unsigned nloc = b.st[0], nx = b.st[1];
        if (nloc == 0u) { xcd_barrier_complete(bar, b.x, nloc, nx); b.st[0] = nloc; b.st[1] = nx; }
        const unsigned old = xb_add(&bar[XB_XSUB(b.x)], 1u);
        const unsigned gen = old / nloc;
        if (old + 1u == (gen + 1u) * nloc) {
            __builtin_amdgcn_fence(__ATOMIC_RELEASE, "agent");
            asm volatile("s_waitcnt vmcnt(0)" ::: "memory");
            const unsigned og = xb_add(&bar[XB_TOP], 1u);
            const unsigned tg = og / nx;
            if (og + 1u == (tg + 1u) * nx) xb_add(&bar[XB_TOPGEN], 1u);
            else XB_SPIN(xb_ld(&bar[XB_TOPGEN]) == tg, bar);
            __builtin_amdgcn_fence(__ATOMIC_ACQUIRE, "agent");
            xb_add(&bar[XB_XGEN(b.x)], 1u);
            asm volatile("s_waitcnt vmcnt(0)" ::: "memory");
        } else {
            XB_SPIN(xb_ld(&bar[XB_XGEN(b.x)]) == gen, bar);
            __builtin_amdgcn_fence(__ATOMIC_ACQUIRE, "agent");
            asm volatile("s_waitcnt vmcnt(0)" ::: "memory");
        }
    }
    __syncthreads();
}

namespace gm {
constexpr int BM = 256, BK = 64, HALF = 128, HTB = HALF * BK * 2, STAGE_BYTES = 8 * HTB, NXCD = 8, WGM = 16;
__device__ __forceinline__ int lds_byte(int r, int c) { const int st = (r >> 4) * 2 + (c >> 5), rr = r & 15, cc = c & 31, ob = rr * 64 + cc * 2; return st * 1024 + (ob ^ (((ob >> 9) & 1) << 5)); }
__device__ __forceinline__ void stage_rc(int b, int& R, int& C) { const int st = b / 1024, sb = b % 1024, swz = sb ^ (((sb >> 9) & 1) << 5); R = (st >> 1) * 16 + swz / 64; C = (st & 1) * 32 + (swz % 64) / 2; }
__device__ __forceinline__ int perm32(int rho) { const int n = rho >> 4, i = rho & 15; return 8 * (i >> 2) + 4 * n + (i & 3); }
struct Unit { int pm, pn, e, mt, li; };

struct DenseOrder {
    int nM, nN, nwg, G, c, KB; const char* A; const char* Bt;
    __device__ __forceinline__ void init(const void* A_, const void* Bt_, int M, int N, int K_, int G_, int c_) { A = (const char*)A_; Bt = (const char*)Bt_; nM = M / BM; nN = N / BM; nwg = nM * nN; G = G_; c = c_; KB = K_ * 2; }
    __device__ __forceinline__ bool next(int i, Unit& u) const {
        const long L = (long)i * G + c; if (L >= nwg) return false;
        int wgid = (int)L; { const int q = nwg / NXCD, r = nwg % NXCD, xcd = wgid % NXCD, off = wgid / NXCD; wgid = (xcd < r ? xcd * (q + 1) : r * (q + 1) + (xcd - r) * q) + off; }
        const int nig = WGM * nN, gid = wgid / nig, fm = gid * WGM, gsz = (nM - fm) < WGM ? (nM - fm) : WGM;
        u.pm = fm + ((wgid % nig) % gsz); u.pn = (wgid % nig) / gsz; u.e = 0; u.mt = 0; u.li = i; return true;
    }
    __device__ __forceinline__ const char* abase() const { return A; }
    __device__ __forceinline__ unsigned aoff(const Unit& u, int r) const { return (unsigned)(u.pm * BM + r) * (unsigned)KB; }
    __device__ __forceinline__ const char* bptr(const Unit& u) const { return Bt + (size_t)u.pn * BM * KB; }
};
struct MoeOrder {
    const LAS int* rt_e; const LAS int* rtbase; const LAS int* tokrow; int nunits, G, c, KB; const char* A; const char* Bt; size_t bexp; bool gather;
    __device__ __forceinline__ bool next(int i, Unit& u) const {
        const long L = (long)i * G + c; if (L >= nunits) return false;
        int wgid = (int)L; { const int q = nunits / NXCD, r = nunits % NXCD, xcd = wgid % NXCD, off = wgid / NXCD; wgid = (xcd < r ? xcd * (q + 1) : r * (q + 1) + (xcd - r) * q) + off; }
        const int rt = wgid >> 2; const int e = __builtin_amdgcn_readfirstlane(rt_e[rt]); const int rb = __builtin_amdgcn_readfirstlane(rtbase[e]);
        u.pm = rt; u.pn = wgid & 3; u.e = e; u.mt = rt - rb; u.li = i; return true;
    }
    __device__ __forceinline__ const char* abase() const { return A; }
    __device__ __forceinline__ unsigned aoff(const Unit& u, int r) const {
        if (gather) { int t = tokrow[u.li * 256 + r] >> 1; t = t < 0 ? 0 : t; return (unsigned)t * (unsigned)KB; }
        return (unsigned)(u.pm * BM + r) * (unsigned)KB;
    }
    __device__ __forceinline__ const char* bptr(const Unit& u) const { return Bt + (size_t)u.e * bexp + (size_t)u.pn * BM * KB; }
};

template <class Epi, class Sched, bool F8 = false>
__device__ __forceinline__ void gemm_phase(LAS unsigned char* lds, const Sched& S, const Epi& E) {
    const int tid = threadIdx.x, wid = __builtin_amdgcn_readfirstlane(tid >> 6), lane = tid & 63, wr = wid >> 2, wc = wid & 3, fr = lane & 15, fq = lane >> 4;
    const int KB = S.KB, nt = KB / (BK * 2);
    int RA[2]; unsigned CA2[2], voffB[2];
#pragma unroll
    for (int i = 0; i < 2; ++i) { int R, C; stage_rc(tid * 16 + i * 8192, R, C); const int Rb = (R & ~31) + perm32(R & 31);
        RA[i] = R; CA2[i] = (unsigned)C * 2u; voffB[i] = (unsigned)(Rb * KB + C * 2); }
    const unsigned kstep = (unsigned)(BK * 2);
    const size_t hstep = (size_t)HALF * KB;
    const unsigned ldsw = (unsigned)wid * 1024u;
    const int aoff = lds_byte(wr * 64 + fr, fq * 8), boff = lds_byte(wc * 32 + fr, fq * 8);
#define GM_SA(b, h) (((b) * 2 + (h)) * HTB)
#define GM_SB(b, h) ((4 + (b) * 2 + (h)) * HTB)
#define GM_STAGE_B(bufoff, gbase) do { _Pragma("unroll") for (int _i = 0; _i < 2; ++_i) \
        __builtin_amdgcn_global_load_lds((const unsigned*)((const char*)(gbase) + voffB[_i]), (LAS unsigned*)(lds + (bufoff) + ldsw + _i * 8192), 16, 0, 0); } while (0)
#define GM_STAGE_A(bufoff, offs, koff) do { _Pragma("unroll") for (int _i = 0; _i < 2; ++_i) \
        __builtin_amdgcn_global_load_lds((const unsigned*)((Ab + (koff)) + (offs)[_i]), (LAS unsigned*)(lds + (bufoff) + ldsw + _i * 8192), 16, 0, 0); } while (0)
#define GM_LD8(p) __builtin_shufflevector(*(const LAS i32x4*)(p), *(const LAS i32x4*)((p) + 1024), 0, 1, 2, 3, 4, 5, 6, 7)
#define GM_LDA(dst, b, h) do { _Pragma("unroll") for (int m = 0; m < 4; ++m) { if constexpr (F8) dst##8[m] = GM_LD8(lds + GM_SA(b, h) + aoff + m * 2048); \
        else { _Pragma("unroll") for (int k = 0; k < 2; ++k) dst[m][k] = *(const LAS bf16x8*)(lds + GM_SA(b, h) + aoff + m * 2048 + k * 1024); } } } while (0)
#define GM_LDB(dst, b, h) do { _Pragma("unroll") for (int n = 0; n < 2; ++n) { if constexpr (F8) dst##8[n] = GM_LD8(lds + GM_SB(b, h) + boff + n * 2048); \
        else { _Pragma("unroll") for (int k = 0; k < 2; ++k) dst[n][k] = *(const LAS bf16x8*)(lds + GM_SB(b, h) + boff + n * 2048 + k * 1024); } } } while (0)
#define GM_MMA(ai, bj, At, Bt) do { __builtin_amdgcn_s_setprio(1); _Pragma("unroll") for (int m = 0; m < 4; ++m) _Pragma("unroll") for (int n = 0; n < 2; ++n) { \
        if constexpr (F8) asm volatile("v_mfma_scale_f32_16x16x128_f8f6f4 %0, %1, %2, %0, %3, %4 op_sel_hi:[0,0,0]" : "+v"(acc[ai][bj][m][n]) : "v"(Bt##8[n]), "v"(At##8[m]), "v"(scW), "v"(scX)); \
        else { _Pragma("unroll") for (int k = 0; k < 2; ++k) acc[ai][bj][m][n] = __builtin_amdgcn_mfma_f32_16x16x32_bf16(Bt[n][k], At[m][k], acc[ai][bj][m][n], 0, 0, 0); } } \
        __builtin_amdgcn_s_setprio(0); } while (0)
#define GM_WAIT_V(n) asm volatile("s_waitcnt vmcnt(" #n ")" ::: "memory")
#define GM_WAIT_L(n) asm volatile("s_waitcnt lgkmcnt(" #n ")" ::: "memory")
#define GM_BAR __builtin_amdgcn_s_barrier()
    Unit cur, nxt; int ui = 0;
    if (!S.next(0, cur)) return;
    f32x4 acc[2][2][4][2];
#pragma unroll
    for (int a = 0; a < 2; ++a)
#pragma unroll
        for (int b = 0; b < 2; ++b)
#pragma unroll
            for (int m = 0; m < 4; ++m)
#pragma unroll
                for (int n = 0; n < 2; ++n) acc[a][b][m][n] = (f32x4){0.f, 0.f, 0.f, 0.f};
    bf16x8 At[4][2], B0[2][2], B1[2][2]; i32x8 At8[4], B08[2], B18[2];
    int scW = 0x7A7A7A7A, scX = 0x7F7F7F7F; asm volatile("" : "+v"(scW), "+v"(scX));
    const char* Ab = S.abase();
    unsigned coff[2][2], noff[2][2];
#pragma unroll
    for (int h = 0; h < 2; ++h)
#pragma unroll
        for (int i = 0; i < 2; ++i) coff[h][i] = S.aoff(cur, h * HALF + RA[i]) + CA2[i];
    const char* cB = S.bptr(cur);
    GM_STAGE_B(GM_SB(0, 0), cB); GM_STAGE_B(GM_SB(0, 1), cB + hstep); GM_STAGE_A(GM_SA(0, 0), coff[0], 0u); GM_STAGE_A(GM_SA(0, 1), coff[1], 0u);
    if (wr == 1) GM_BAR;
    GM_WAIT_V(2); GM_BAR;
    GM_STAGE_B(GM_SB(1, 0), cB + kstep); GM_STAGE_A(GM_SA(1, 0), coff[0], kstep); GM_STAGE_B(GM_SB(1, 1), cB + hstep + kstep);
    GM_WAIT_V(6); GM_BAR;
    for (;;) {
        const bool has_next = S.next(ui + 1, nxt);
        const char* nB = has_next ? S.bptr(nxt) : cB;
#pragma unroll
        for (int h = 0; h < 2; ++h)
#pragma unroll
            for (int i = 0; i < 2; ++i) noff[h][i] = has_next ? (S.aoff(nxt, h * HALF + RA[i]) + CA2[i]) : coff[h][i];
        for (int t = 0; t < nt; t += 2) {
            const bool last = (t == nt - 2);
            const unsigned k1 = (unsigned)(t + 1) * kstep;
            const unsigned k2 = last ? 0u : (unsigned)(t + 2) * kstep, k3 = k2 + kstep;
            const char* b2 = last ? nB : cB + (size_t)(t + 2) * kstep; const char* b3 = b2 + kstep;
            unsigned s2[2][2];
#pragma unroll
            for (int h = 0; h < 2; ++h)
#pragma unroll
                for (int i = 0; i < 2; ++i) s2[h][i] = last ? noff[h][i] : coff[h][i];
            GM_LDB(B0, 0, 0); GM_LDB(B1, 0, 1); SBAR(); GM_LDA(At, 0, 0); GM_STAGE_A(GM_SA(1, 1), coff[1], k1);
            GM_WAIT_V(8); GM_WAIT_L(0); GM_BAR; GM_MMA(0, 0, At, B0); GM_MMA(0, 1, At, B1); GM_BAR; SBAR();
            GM_LDA(At, 0, 1); GM_STAGE_B(GM_SB(0, 0), b2); GM_STAGE_B(GM_SB(0, 1), b2 + hstep); GM_STAGE_A(GM_SA(0, 0), s2[0], k2);
            GM_WAIT_V(8); GM_WAIT_L(0); GM_BAR; GM_MMA(1, 0, At, B0); GM_MMA(1, 1, At, B1); GM_BAR; SBAR();
            GM_LDB(B0, 1, 0); GM_LDB(B1, 1, 1); SBAR(); GM_LDA(At, 1, 0); GM_STAGE_A(GM_SA(0, 1), s2[1], k2);
            GM_WAIT_V(8); GM_WAIT_L(0); GM_BAR; GM_MMA(0, 0, At, B0); GM_MMA(0, 1, At, B1); GM_BAR; SBAR();
            GM_LDA(At, 1, 1); GM_STAGE_B(GM_SB(1, 0), b3); GM_STAGE_B(GM_SB(1, 1), b3 + hstep); GM_STAGE_A(GM_SA(1, 0), s2[0], k3);
            GM_WAIT_V(8); GM_WAIT_L(0); GM_BAR; GM_MMA(1, 0, At, B0); GM_MMA(1, 1, At, B1); GM_BAR; SBAR();
        }
        if (wr == 0) GM_BAR;
        if constexpr (F8) asm volatile("s_nop 15\n\ts_nop 15" ::: "memory");
        E(acc, cur, wr, wc, fr, fq);
        if (!has_next) break;
#pragma unroll
        for (int a = 0; a < 2; ++a)
#pragma unroll
            for (int b = 0; b < 2; ++b)
#pragma unroll
                for (int m = 0; m < 4; ++m)
#pragma unroll
                    for (int n = 0; n < 2; ++n) acc[a][b][m][n] = (f32x4){0.f, 0.f, 0.f, 0.f};
        cur = nxt; cB = nB; ++ui;
#pragma unroll
        for (int h = 0; h < 2; ++h)
#pragma unroll
            for (int i = 0; i < 2; ++i) coff[h][i] = noff[h][i];
        if (wr == 1) GM_BAR;
    }
    GM_WAIT_V(0);
    GM_BAR;
#undef GM_SA
#undef GM_SB
#undef GM_STAGE_A
#undef GM_STAGE_B
#undef GM_LD8
#undef GM_LDA
#undef GM_LDB
#undef GM_MMA
#undef GM_WAIT_V
#undef GM_WAIT_L
#undef GM_BAR
}

constexpr float QSCALE = 0.125f * 1.4426950408889634f;
struct EpiQKVU {
    bf16_t* Q; bf16_t* Kb; bf16_t* V; bf16_t* U; const float* rope;
    __device__ __forceinline__ void operator()(const f32x4 (&acc)[2][2][4][2], const Unit& u, int wr, int wc, int fr, int fq) const {
        const int kind = u.pn >> 1;
        bf16_t* base = kind == 0 ? Q : (kind == 1 ? Kb : (kind == 2 ? V : U));
        const int row0 = u.pm * BM + wr * 64 + fr, col0 = (u.pn & 1) * 256 + wc * 32 + 8 * fq;
        const bool dorope = (kind < 2) && ((wc & 1) == 0);
#pragma unroll
        for (int ai = 0; ai < 2; ++ai)
#pragma unroll
            for (int m = 0; m < 4; ++m) {
                const int row = row0 + ai * HALF + m * 16;
                bf16_t* rowp = base + (size_t)row * 512 + col0;
                f32x4 c0 = {1.f, 1.f, 1.f, 1.f}, c1 = c0, s0 = {0.f, 0.f, 0.f, 0.f}, s1 = s0;
                if (dorope) { const float* rp = rope + (size_t)(row & (SEQ - 1)) * 16; c0 = *(const f32x4*)(rp); c1 = *(const f32x4*)(rp + 4); s0 = *(const f32x4*)(rp + 8); s1 = *(const f32x4*)(rp + 12);
                    if (fq == 0) { s0 = -s0; s1 = -s1; } if (fq >= 2) { c0 = (f32x4){1.f, 1.f, 1.f, 1.f}; c1 = c0; s0 = (f32x4){0.f, 0.f, 0.f, 0.f}; s1 = s0; } }
#pragma unroll
                for (int bj = 0; bj < 2; ++bj) {
                    f32x4 v0 = acc[ai][bj][m][0], v1 = acc[ai][bj][m][1];
                    if (dorope) {
                        f32x4 p0, p1;
#pragma unroll
                        for (int j = 0; j < 4; ++j) { p0[j] = __shfl_xor(v0[j], 16); p1[j] = __shfl_xor(v1[j], 16); }
                        v0 = v0 * c0 + p0 * s0; v1 = v1 * c1 + p1 * s1;
                    }
                    if (kind == 0) { v0 = v0 * QSCALE; v1 = v1 * QSCALE; }
                    u32x4 w; w.x = cvt_pk_bf16(v0[0], v0[1]); w.y = cvt_pk_bf16(v0[2], v0[3]); w.z = cvt_pk_bf16(v1[0], v1[1]); w.w = cvt_pk_bf16(v1[2], v1[3]);
                    *(u32x4*)(rowp + bj * HALF) = w;
                }
            }
    }
};
struct EpiMix {
    bf16_t* D; const float* g1;
    __device__ __forceinline__ void operator()(const f32x4 (&acc)[2][2][4][2], const Unit& u, int wr, int wc, int fr, int fq) const {
        const int row0 = u.pm * BM + wr * 64 + fr, col0 = u.pn * BM + wc * 32 + 8 * fq, b = (u.pm * BM) >> 11;
        f32x4 gv[2][2];
#pragma unroll
        for (int bj = 0; bj < 2; ++bj)
#pragma unroll
            for (int n = 0; n < 2; ++n) gv[bj][n] = *(const f32x4*)(g1 + (size_t)b * 6144 + col0 + bj * HALF + 4 * n);
#pragma unroll
        for (int ai = 0; ai < 2; ++ai)
#pragma unroll
            for (int m = 0; m < 4; ++m) { bf16_t* rowp = D + (size_t)(row0 + ai * HALF + m * 16) * DM + col0;
#pragma unroll
                for (int bj = 0; bj < 2; ++bj) { const f32x4 v0 = gv[bj][0] * acc[ai][bj][m][0], v1 = gv[bj][1] * acc[ai][bj][m][1];
                    u32x4 w; w.x = cvt_pk_bf16(v0[0], v0[1]); w.y = cvt_pk_bf16(v0[2], v0[3]); w.z = cvt_pk_bf16(v1[0], v1[1]); w.w = cvt_pk_bf16(v1[2], v1[3]);
                    *(u32x4*)(rowp + bj * HALF) = w; } }
    }
};
struct EpiGateUp {
    unsigned char* HID;
    __device__ __forceinline__ void operator()(const f32x4 (&acc)[2][2][4][2], const Unit& u, int wr, int wc, int fr, int fq) const {
        const int row0 = u.pm * BM + wr * 64 + fr, col0 = u.pn * HALF + wc * 32 + 8 * fq;
#pragma unroll
        for (int ai = 0; ai < 2; ++ai)
#pragma unroll
            for (int m = 0; m < 4; ++m) { float h[8];
#pragma unroll
                for (int n = 0; n < 2; ++n)
#pragma unroll
                    for (int j = 0; j < 4; ++j) { const float g = acc[ai][0][m][n][j], up = acc[ai][1][m][n][j];
                        h[n * 4 + j] = g * up * __builtin_amdgcn_rcpf(1.f + __builtin_amdgcn_exp2f(-1.4426950408889634f * g)); }
                u32x2 w; w.x = pk4_fp8(h[0], h[1], h[2], h[3]); w.y = pk4_fp8(h[4], h[5], h[6], h[7]);
                *(u32x2*)(HID + (size_t)(row0 + ai * HALF + m * 16) * DEXP + col0) = w; }
    }
};
struct EpiDown {
    unsigned char* YS; const LAS int* tokrow; const LAS float* wrow;
    __device__ __forceinline__ void operator()(const f32x4 (&acc)[2][2][4][2], const Unit& u, int wr, int wc, int fr, int fq) const {
        const int r0 = wr * 64 + fr, col0 = u.pn * BM + wc * 32 + 8 * fq;
#pragma unroll
        for (int ai = 0; ai < 2; ++ai)
#pragma unroll
            for (int m = 0; m < 4; ++m) { const int r = r0 + ai * HALF + m * 16; const int dest = tokrow[u.li * 256 + r]; const float w8 = wrow[u.li * 256 + r];
                if (dest >= 0) {
#pragma unroll
                    for (int bj = 0; bj < 2; ++bj) { const f32x4 v0 = acc[ai][bj][m][0] * (w8 * 16.f), v1 = acc[ai][bj][m][1] * (w8 * 16.f);
                        u32x2 w; w.x = pk4_fp8(v0[0], v0[1], v0[2], v0[3]); w.y = pk4_fp8(v1[0], v1[1], v1[2], v1[3]);
                        *(u32x2*)(YS + (size_t)dest * DM + col0 + bj * HALF) = w; } } }
    }
};
}

namespace att {
constexpr int QBLK = 32, KVBLK = 64, LDK = 512;
constexpr float THRL = 8.f;
constexpr int SHM_V = KVBLK * 128 * 2, SHM_K = KVBLK * 128 * 2;
constexpr int SLOT = SHM_V + SHM_K, NSLOT = 3;
constexpr int OFF_WS = NSLOT * SLOT, OFF_XCH = 0  , ATT_LDS = OFF_WS + NWAVES * 64 * 4;
static_assert(4 * 64 * 64 * 4 <= 2 * SLOT, "exchange block fits two ring slots");
static_assert(ATT_LDS <= RING_BYTES, "attention LDS");
#define KSWZ(row, colB) ((row) * 256 + ((colB) ^ (((row) & 7) << 4)))
__device__ __forceinline__ int crow(int r, int hi) { return (r & 3) + 8 * (r >> 2) + 4 * hi; }
template <bool FIRST>
__device__ __forceinline__ void partialSM(f32x16& p0, f32x16& p1, float& mhat, float& alpha) {
    float a = fmaxf(fmaxf(p0[0], p0[1]), p1[0]), b = fmaxf(fmaxf(p0[2], p0[3]), p1[1]); a = fmaxf(fmaxf(a, p1[2]), p1[3]);
#pragma unroll
    for (int r = 4; r < 16; r += 4) { a = fmaxf(fmaxf(a, p0[r]), p0[r + 1]); b = fmaxf(fmaxf(b, p0[r + 2]), p0[r + 3]); a = fmaxf(fmaxf(a, p1[r]), p1[r + 1]); b = fmaxf(fmaxf(b, p1[r + 2]), p1[r + 3]); }
    float pmax = fmaxf(a, b);
    { auto rr = __builtin_amdgcn_permlane32_swap(__float_as_uint(pmax), __float_as_uint(pmax), false, false); pmax = fmaxf(__uint_as_float(rr[0]), __uint_as_float(rr[1])); }
    alpha = 1.f;
    if (FIRST || !__builtin_expect(__all(pmax <= THRL), 1)) {
        const float dl = FIRST ? pmax : fmaxf(pmax, 0.f);
        mhat += dl;
#pragma unroll
        for (int r = 0; r < 16; ++r) { p0[r] -= dl; p1[r] -= dl; }
        if (!FIRST) alpha = __builtin_amdgcn_exp2f(-dl);
    }
#pragma unroll
    for (int r = 0; r < 16; ++r) p0[r] = __builtin_amdgcn_exp2f(p0[r]);
}
__device__ __forceinline__ void finishSM(f32x16& p0, f32x16& p1, float alpha, float& l_reg, bf16x8& pa0, bf16x8& pa1, bf16x8& pa2, bf16x8& pa3) {
#pragma unroll
    for (int r = 0; r < 16; ++r) p1[r] = __builtin_amdgcn_exp2f(p1[r]);
    float ps = 0;
#pragma unroll
    for (int r = 0; r < 16; ++r) ps += p0[r];
#pragma unroll
    for (int r = 0; r < 16; ++r) ps += p1[r];
    { auto rr = __builtin_amdgcn_permlane32_swap(__float_as_uint(ps), __float_as_uint(ps), false, false); ps = __uint_as_float(rr[0]) + __uint_as_float(rr[1]); }
    l_reg = l_reg * alpha + ps;
#define PK4(P, BASE, OUT) do { unsigned a0 = cvt_pk_bf16(P[BASE + 0], P[BASE + 1]), a1 = cvt_pk_bf16(P[BASE + 2], P[BASE + 3]);   \
    unsigned b0 = cvt_pk_bf16(P[BASE + 4], P[BASE + 5]), b1 = cvt_pk_bf16(P[BASE + 6], P[BASE + 7]);                              \
    auto r0 = __builtin_amdgcn_permlane32_swap(a0, b0, false, false); auto r1 = __builtin_amdgcn_permlane32_swap(a1, b1, false, false); \
    u32x4 w = {r0[0], r1[0], r0[1], r1[1]}; OUT = *reinterpret_cast<bf16x8*>(&w); } while (0)
    PK4(p0, 0, pa0); PK4(p0, 8, pa1); PK4(p1, 0, pa2); PK4(p1, 8, pa3);
#undef PK4
}
__device__ __forceinline__ void qkt(f32x16& p0, f32x16& p1, const char* Ks, const bf16x8* qr, const float mhat, int r32, int hi, int kc0) {
    f32x16 negm;
#pragma unroll
    for (int r = 0; r < 16; ++r) negm[r] = -mhat;
    bf16x8 k0[4], k1[4];
#pragma unroll
    for (int d0 = 0; d0 < 4; ++d0) { const int cb = (kc0 + d0 * 16 + hi * 8) * 2; k0[d0] = *reinterpret_cast<const bf16x8*>(Ks + KSWZ(r32, cb)); k1[d0] = *reinterpret_cast<const bf16x8*>(Ks + KSWZ(32 + r32, cb)); }
    __builtin_amdgcn_sched_barrier(0x2 | 0x4 | 0x400);
    p0 = __builtin_amdgcn_mfma_f32_32x32x16_bf16(k0[0], qr[0], negm, 0, 0, 0); p1 = __builtin_amdgcn_mfma_f32_32x32x16_bf16(k1[0], qr[0], negm, 0, 0, 0);
#pragma unroll
    for (int d0 = 1; d0 < 4; ++d0) { p0 = __builtin_amdgcn_mfma_f32_32x32x16_bf16(k0[d0], qr[d0], p0, 0, 0, 0); p1 = __builtin_amdgcn_mfma_f32_32x32x16_bf16(k1[d0], qr[d0], p1, 0, 0, 0); }
}
__device__ __forceinline__ int v_st(int k, int c) { const int kk = (k & ~0xC) | ((k & 4) << 1) | ((k & 8) >> 1); return ((kk >> 3) * 4 + (c >> 5)) * 512 + ((kk & 7) * 32 + (c & 31)) * 2; }
__device__ __forceinline__ int v_rd_base(int lane) { return ((lane & 3) << 3) | (((lane >> 2) & 3) << 6) | (((lane >> 4) & 1) << 5) | (((lane >> 5) & 1) << 8); }
constexpr int v_rd_off(int d0, int ks, int half) { return d0 * 512 + ks * 4096 + half * 2048; }
template <int OFF> __device__ __forceinline__ s16x4 tr_read(int vb) { s16x4 r; asm volatile("ds_read_b64_tr_b16 %0, %1 offset:%2" : "=&v"(r) : "v"(vb), "i"(OFF) : "memory"); return r; }
struct VFrag { s16x4 l0, h0, l1, h1, l2, h2, l3, h3; };
template <int D0> __device__ __forceinline__ void v_reads(VFrag& f, int vb) {
    f.l0 = tr_read<v_rd_off(D0, 0, 0)>(vb); f.h0 = tr_read<v_rd_off(D0, 0, 1)>(vb); f.l1 = tr_read<v_rd_off(D0, 1, 0)>(vb); f.h1 = tr_read<v_rd_off(D0, 1, 1)>(vb);
    f.l2 = tr_read<v_rd_off(D0, 2, 0)>(vb); f.h2 = tr_read<v_rd_off(D0, 2, 1)>(vb); f.l3 = tr_read<v_rd_off(D0, 3, 0)>(vb); f.h3 = tr_read<v_rd_off(D0, 3, 1)>(vb);
}
__device__ __forceinline__ void pv_mma(f32x16& od, const VFrag& f, bf16x8 pa0, bf16x8 pa1, bf16x8 pa2, bf16x8 pa3) {
#define PK(L, H) (bf16x8){L[0], L[1], L[2], L[3], H[0], H[1], H[2], H[3]}
    od = __builtin_amdgcn_mfma_f32_32x32x16_bf16(pa0, PK(f.l0, f.h0), od, 0, 0, 0);
    od = __builtin_amdgcn_mfma_f32_32x32x16_bf16(pa1, PK(f.l1, f.h1), od, 0, 0, 0);
    od = __builtin_amdgcn_mfma_f32_32x32x16_bf16(pa2, PK(f.l2, f.h2), od, 0, 0, 0);
    od = __builtin_amdgcn_mfma_f32_32x32x16_bf16(pa3, PK(f.l3, f.h3), od, 0, 0, 0);
#undef PK
}
__device__ __forceinline__ void pv_d0(f32x16* o, int vb, bf16x8 pa0, bf16x8 pa1, bf16x8 pa2, bf16x8 pa3) {
    VFrag fa, fb;
    v_reads<0>(fa, vb);
    asm volatile("s_waitcnt lgkmcnt(0)" ::: "memory"); SBAR();
    v_reads<1>(fb, vb); SBAR();
    pv_mma(o[0], fa, pa0, pa1, pa2, pa3); SBAR();
    asm volatile("s_waitcnt lgkmcnt(0)" ::: "memory"); SBAR();
    v_reads<2>(fa, vb); SBAR();
    pv_mma(o[1], fb, pa0, pa1, pa2, pa3); SBAR();
    asm volatile("s_waitcnt lgkmcnt(0)" ::: "memory"); SBAR();
    v_reads<3>(fb, vb); SBAR();
    pv_mma(o[2], fa, pa0, pa1, pa2, pa3); SBAR();
    asm volatile("s_waitcnt lgkmcnt(0)" ::: "memory"); SBAR();
    pv_mma(o[3], fb, pa0, pa1, pa2, pa3);
}
constexpr int OFF_LAND = OFF_WS + NWAVES * 64 * 4;
static_assert(OFF_LAND + NWAVES * 4096 <= RING_BYTES, "landing buffers fit the phase scratch");
struct Weave { const float* wg; const float* wu; const float* wd; unsigned char* dgu; unsigned char* dd; int next, end, pend; };
__device__ __forceinline__ void weave_decode(const Weave& W, int B, int wid, const float*& src, int& ldw, unsigned char*& dst, int& ldd, int& n0, int& isup, int& type) {
    const int mat = B >> 6, within = B & 63, e = mat & 31; type = mat >> 5;
    int kblk, nblk;
    if (type < 2) { src = (type ? W.wu : W.wg) + (size_t)e * DM * DEXP; ldw = DEXP; kblk = within >> 3; nblk = within & 7; dst = W.dgu + (size_t)e * DM * DM; ldd = DM; }
    else { src = W.wd + (size_t)e * DEXP * DM; ldw = DM; kblk = within >> 4; nblk = within & 15; dst = W.dd + (size_t)e * DM * DEXP; ldd = DEXP; }
    isup = type == 1; n0 = nblk * 64;
    src += (size_t)(kblk * 128 + wid * 16) * ldw + n0; dst += kblk * 128 + wid * 16;
}
__device__ __forceinline__ void weave_step(Weave& W, char* lds, LAS unsigned char* ldsl, int wid, int lane) {
    if (W.pend >= 0) {
        const float* src; int ldw, ldd, n0, isup, type; unsigned char* dst;
        weave_decode(W, W.pend, wid, src, ldw, dst, ldd, n0, isup, type);
        const float* land = (const float*)(lds + OFF_LAND + wid * 4096) + lane;
        float v[16];
#pragma unroll
        for (int i = 0; i < 16; ++i) v[i] = land[i * 64] * 32.f;
        u32x4 o; o.x = pk4_fp8(v[0], v[1], v[2], v[3]); o.y = pk4_fp8(v[4], v[5], v[6], v[7]); o.z = pk4_fp8(v[8], v[9], v[10], v[11]); o.w = pk4_fp8(v[12], v[13], v[14], v[15]);
        const int n = n0 + lane; const int drow = type < 2 ? (256 * (n >> 7) + 128 * isup + (n & 127)) : n;
        *(GAS u32x4*)(dst + (size_t)drow * ldd) = o;
        asm volatile("s_waitcnt lgkmcnt(0)" ::: "memory");
        W.pend = -1;
    }
    if (W.next < W.end) {
        const float* src; int ldw, ldd, n0, isup, type; unsigned char* dst;
        weave_decode(W, W.next, wid, src, ldw, dst, ldd, n0, isup, type);
        const float* sp = src + lane;
#pragma unroll
        for (int i = 0; i < 16; ++i) __builtin_amdgcn_global_load_lds((const unsigned*)(sp + (size_t)i * ldw), (LAS unsigned*)(ldsl + OFF_LAND + wid * 4096 + i * 256), 4, 0, 0);
        W.pend = W.next; ++W.next;
    }
}
__device__ __forceinline__ void attn_unit(const bf16_t* __restrict__ Qg, const bf16_t* __restrict__ Kg, const bf16_t* __restrict__ Vg, bf16_t* MIX,
                                          int b, int h, int qblk, float lam, const float* __restrict__ subg, char* lds, LAS unsigned char* ldsl, Weave& wv) {
    const int tid = threadIdx.x, wid = __builtin_amdgcn_readfirstlane(tid >> 6), lane = tid & 63, r32 = lane & 31, hi = lane >> 5;
    const int comp = wid >> 2, wq = wid & 3;
    float* wsf = (float*)(lds + OFF_WS) + wid * 64; float* li_l = wsf; float* al_l = wsf + 32;
    float* xch = (float*)(lds + OFF_XCH) + wq * 4096;
    const long tok0 = (long)b * SEQ;
    float mhat = 0.f, l_reg = 0; f32x16 o[4] = {}; bf16x8 qr[4];
    const bf16_t* Qw = Qg + (tok0 + qblk * 128 + wq * QBLK + r32) * 512 + h * 128 + comp * 64 + hi * 8;
#pragma unroll
    for (int d0 = 0; d0 < 4; ++d0) qr[d0] = *reinterpret_cast<const bf16x8*>(Qw + d0 * 16);
    const char* Kb = (const char*)(Kg + tok0 * 512 + h * 128); const char* Vb = (const char*)(Vg + tok0 * 512 + h * 128);
    unsigned koff[2], voff[2];
#pragma unroll
    for (int i = 0; i < 2; ++i) { const int p_ = (wid * 2 + i) * 1024 + 16 * lane;
        { const int row = p_ >> 8, colB = (p_ & 255) ^ ((row & 7) << 4); koff[i] = (unsigned)(row * 1024 + colB); }
        { const int sub = p_ >> 9, kk = (sub >> 2) * 8 + ((p_ & 511) >> 6), c = (sub & 3) * 32 + (((p_ & 511) >> 1) & 31);
          const int k = (kk & ~0xC) | ((kk & 4) << 1) | ((kk & 8) >> 1); voff[i] = (unsigned)(k * 1024 + c * 2); } }
    const int vb0 = (int)(uintptr_t)lds + v_rd_base(lane);
    const int kc0 = comp * 64;
#define DMA_TILE(t, so) do { const char* kb_ = Kb + (size_t)(t) * (KVBLK * 1024); const char* vb_ = Vb + (size_t)(t) * (KVBLK * 1024); \
    _Pragma("unroll") for (int i_ = 0; i_ < 2; ++i_) { \
        __builtin_amdgcn_global_load_lds((const unsigned*)(vb_ + voff[i_]), (LAS unsigned*)(ldsl + (so) + (wid * 2 + i_) * 1024), 16, 0, 0); \
        __builtin_amdgcn_global_load_lds((const unsigned*)(kb_ + koff[i_]), (LAS unsigned*)(ldsl + (so) + SHM_V + (wid * 2 + i_) * 1024), 16, 0, 0); } } while (0)
#define WAIT_BAR(N) asm volatile("s_waitcnt vmcnt(" #N ") lgkmcnt(0)\n\ts_barrier" ::: "memory")
#define RESC(a) do { if (__any((a) < 1.f)) { if (hi == 0) al_l[r32] = (a); asm volatile("s_waitcnt lgkmcnt(0)" ::: "memory"); \
    _Pragma("unroll") for (int d = 0; d < 4; ++d) _Pragma("unroll") for (int r = 0; r < 16; ++r) o[d][r] *= al_l[crow(r, hi)]; } } while (0)
    f32x16 pA0, pA1, pB0, pB1; float alA, alB; bf16x8 pa0, pa1, pa2, pa3; constexpr int NT = SEQ / KVBLK;
    DMA_TILE(0, 0); DMA_TILE(1, SLOT);
    WAIT_BAR(4);
    qkt(pA0, pA1, lds + SHM_V, qr, mhat, r32, hi, kc0); partialSM<true>(pA0, pA1, mhat, alA);
    DMA_TILE(2, 2 * SLOT);
    WAIT_BAR(4);
    int s_prev = 0, s_cur = SLOT, s_next = 2 * SLOT;
#define ROT() do { const int t_ = s_prev; s_prev = s_cur; s_cur = s_next; s_next = t_; } while (0)
    for (int j = 1; j + 1 < NT; j += 2) {
        SBAR(); qkt(pB0, pB1, lds + s_cur + SHM_V, qr, mhat, r32, hi, kc0);
        finishSM(pA0, pA1, alA, l_reg, pa0, pa1, pa2, pa3); SBAR();
        pv_d0(o, vb0 + s_prev, pa0, pa1, pa2, pa3); partialSM<false>(pB0, pB1, mhat, alB);
        WAIT_BAR(0);
        if (j + 2 < NT) DMA_TILE(j + 2, s_prev);
        RESC(alB); ROT();
        SBAR(); qkt(pA0, pA1, lds + s_cur + SHM_V, qr, mhat, r32, hi, kc0);
        finishSM(pB0, pB1, alB, l_reg, pa0, pa1, pa2, pa3); SBAR();
        pv_d0(o, vb0 + s_prev, pa0, pa1, pa2, pa3); partialSM<false>(pA0, pA1, mhat, alA);
        WAIT_BAR(0);
        if (j + 3 < NT) DMA_TILE(j + 3, s_prev);
        weave_step(wv, lds, ldsl, wid, lane);
        RESC(alA); ROT();
    }
    SBAR(); qkt(pB0, pB1, lds + s_cur + SHM_V, qr, mhat, r32, hi, kc0);
    finishSM(pA0, pA1, alA, l_reg, pa0, pa1, pa2, pa3); SBAR();
    pv_d0(o, vb0 + s_prev, pa0, pa1, pa2, pa3); partialSM<false>(pB0, pB1, mhat, alB);
    RESC(alB);
    finishSM(pB0, pB1, alB, l_reg, pa0, pa1, pa2, pa3); SBAR();
    pv_d0(o, vb0 + s_cur, pa0, pa1, pa2, pa3);
    asm volatile("s_waitcnt lgkmcnt(0)\n\ts_barrier" ::: "memory");
    if (hi == 0) li_l[r32] = l_reg; asm volatile("s_waitcnt lgkmcnt(0)" ::: "memory");
    float rli[16];
#pragma unroll
    for (int r = 0; r < 16; ++r) rli[r] = __builtin_amdgcn_rcpf(li_l[crow(r, hi)]);
    if (comp == 1) {
#pragma unroll
        for (int d0 = 0; d0 < 4; ++d0)
#pragma unroll
            for (int r = 0; r < 16; ++r) xch[(d0 * 16 + r) * 64 + lane] = o[d0][r] * rli[r];
    }
    __syncthreads();
    if (comp == 0) {
        float rn[16];
#pragma unroll
        for (int r = 0; r < 16; ++r) { float s = 0.f;
#pragma unroll
            for (int d0 = 0; d0 < 4; ++d0) { const float v = o[d0][r] * rli[r] - lam * xch[(d0 * 16 + r) * 64 + lane]; o[d0][r] = v; s += v * v; }
            s += __shfl_xor(s, 1); s += __shfl_xor(s, 2); s += __shfl_xor(s, 4); s += __shfl_xor(s, 8); s += __shfl_xor(s, 16);
            rn[r] = __builtin_amdgcn_rsqf(s * (1.f / 128.f) + RMS_EPS) * 0.8f; }
        float gs[4];
#pragma unroll
        for (int d0 = 0; d0 < 4; ++d0) gs[d0] = subg[d0 * 32 + r32];
        asm volatile("s_waitcnt lgkmcnt(0)" ::: "memory");
        bf16_t* stg = (bf16_t*)xch;
#pragma unroll
        for (int r = 0; r < 16; ++r) { const int orow = crow(r, hi);
#pragma unroll
            for (int d0 = 0; d0 < 4; ++d0) stg[orow * 128 + d0 * 32 + r32] = (bf16_t)f2bf(o[d0][r] * rn[r] * gs[d0]); }
        asm volatile("s_waitcnt lgkmcnt(0)" ::: "memory");
        bf16_t* Ow = MIX + (tok0 + qblk * 128 + wq * QBLK) * 1024 + h * 128;
#pragma unroll
        for (int i = 0; i < 8; ++i) { const int row = i * 4 + (lane >> 4), ch = lane & 15; const u32x4 v = *(const u32x4*)(stg + row * 128 + ch * 8); *(u32x4*)(Ow + (long)row * 1024 + ch * 8) = v; }
    }
    asm volatile("s_waitcnt lgkmcnt(0)" ::: "memory");
    __syncthreads();
#undef DMA_TILE
#undef WAIT_BAR
#undef ROT
#undef RESC
}
#undef KSWZ
}

struct Params {
    const float *x, *c, *w_ada, *b_ada, *norm1_g, *w_in, *lq1, *lk1, *lq2, *lk2, *subln_g, *w_pool, *pool_scale, *w_out, *norm2_g, *w_rg, *b_rg, *w_re, *b_re, *w_gate, *w_up, *w_down, *final_g;
    float* out; unsigned char* ws; long long ph;
};
struct Frame { LAS unsigned char* lds; int tid, lane, wave, vcu, G; };

__device__ __forceinline__ void transpose_item(const float* W, int ldw, int k0, int n0, bf16_t* WT, size_t drow0, int ldd, int dcol0, LAS float* scr, int lane) {
#pragma unroll 8
    for (int i = 0; i < 32; ++i) { const int kk = 2 * i + (lane >> 5); scr[kk * 33 + (lane & 31)] = W[(size_t)(k0 + kk) * ldw + n0 + (lane & 31)]; }
    LDS_WAIT(); asm volatile("" ::: "memory");
    const int c = lane & 7;
#pragma unroll
    for (int j = 0; j < 4; ++j) { const int n = (lane >> 3) + 8 * j; const LAS float* s = scr + (8 * c) * 33 + n;
        u32x4 o; o.x = cvt_pk_bf16(s[0 * 33], s[1 * 33]); o.y = cvt_pk_bf16(s[2 * 33], s[3 * 33]); o.z = cvt_pk_bf16(s[4 * 33], s[5 * 33]); o.w = cvt_pk_bf16(s[6 * 33], s[7 * 33]);
        *(GAS u32x4*)(WT + (drow0 + n) * (size_t)ldd + dcol0 + 8 * c) = o; }
    LDS_WAIT(); asm volatile("" ::: "memory");
}
__device__ __forceinline__ void transpose_item_f8(const float* W, int ldw, int k0, int n0, unsigned char* WT, size_t drow0, int ldd, int dcol0, LAS float* scr, int lane) {
#pragma unroll 8
    for (int i = 0; i < 32; ++i) { const int kk = 2 * i + (lane >> 5); scr[kk * 33 + (lane & 31)] = W[(size_t)(k0 + kk) * ldw + n0 + (lane & 31)] * 32.f; }
    LDS_WAIT(); asm volatile("" ::: "memory");
    const int c = lane & 3;
#pragma unroll
    for (int j = 0; j < 2; ++j) { const int n = (lane >> 2) + 16 * j; const LAS float* s = scr + (16 * c) * 33 + n;
        u32x4 o; o.x = pk4_fp8(s[0 * 33], s[1 * 33], s[2 * 33], s[3 * 33]); o.y = pk4_fp8(s[4 * 33], s[5 * 33], s[6 * 33], s[7 * 33]);
        o.z = pk4_fp8(s[8 * 33], s[9 * 33], s[10 * 33], s[11 * 33]); o.w = pk4_fp8(s[12 * 33], s[13 * 33], s[14 * 33], s[15 * 33]);
        *(GAS u32x4*)(WT + (drow0 + n) * (size_t)ldd + dcol0 + 16 * c) = o; }
    LDS_WAIT(); asm volatile("" ::: "memory");
}
__device__ __forceinline__ void p0_prologue(const Params& P, Frame& F) {
    LAS float* scr = (LAS float*)(F.lds + F.wave * 16384);
    const int gw = F.vcu * NWAVES + F.wave, NGW = F.G * NWAVES, lane = F.lane;
    unsigned char* ws = P.ws;
    constexpr int T_MOD = 768, T_WF = 512, T_ROPE = 256, T_WR = 768, I_WIN = 1024, I_WOUT = 256;
    constexpr int NITEMS = T_MOD + T_WF + T_ROPE + T_WR + I_WIN + I_WOUT;
    for (int it = gw; it < NITEMS; it += NGW) {
        int r = it;
        if (r < T_MOD) {
            const int nc = r >> 3, kq = r & 7, n0 = nc * 64;
            for (int idx = lane; idx < 2048; idx += 64) { const int b = idx & 15, kk = idx >> 4; const float v = P.c[b * DM + kq * 128 + kk]; scr[kk * 16 + b] = v / (1.f + __expf(-v)); }
            LDS_WAIT(); asm volatile("" ::: "memory");
            float acc[16];
#pragma unroll
            for (int b = 0; b < 16; ++b) acc[b] = 0.f;
            const float* wp = P.w_ada + (size_t)(kq * 128) * 6144 + n0 + lane;
#pragma unroll 8
            for (int kk = 0; kk < 128; ++kk) { const float w = wp[(size_t)kk * 6144];
#pragma unroll
                for (int b4 = 0; b4 < 4; ++b4) { const f32x4 s = *(const LAS f32x4*)(scr + kk * 16 + b4 * 4); acc[b4 * 4 + 0] += w * s[0]; acc[b4 * 4 + 1] += w * s[1]; acc[b4 * 4 + 2] += w * s[2]; acc[b4 * 4 + 3] += w * s[3]; } }
            float* mp = (float*)(ws + WS_MODP) + (size_t)(kq * 16) * 6144 + n0 + lane;
#pragma unroll
            for (int b = 0; b < 16; ++b) mp[(size_t)b * 6144] = acc[b];
            LDS_WAIT(); asm volatile("" ::: "memory");
            continue; }
        r -= T_MOD;
        if (r < T_WF) {
            const int g = r >> 7, cc = (r >> 4) & 7, nc = r & 15, c0 = cc * 16, n0 = nc * 64;
            for (int idx = lane; idx < 2048; idx += 64) { const int d = idx & 127, c = idx >> 7; scr[d * 16 + c] = P.w_pool[(size_t)(g * 128 + c0 + c) * 128 + d] * P.pool_scale[g * 128 + d]; }
            LDS_WAIT(); asm volatile("" ::: "memory");
            float acc[16];
#pragma unroll
            for (int c = 0; c < 16; ++c) acc[c] = 0.f;
            const float* wp = P.w_out + (size_t)(512 + g * 128) * DM + n0 + lane;
#pragma unroll 8
            for (int d = 0; d < 128; ++d) { const float w = wp[(size_t)d * DM];
#pragma unroll
                for (int c4 = 0; c4 < 4; ++c4) { const f32x4 s = *(const LAS f32x4*)(scr + d * 16 + c4 * 4); acc[c4 * 4 + 0] += w * s[0]; acc[c4 * 4 + 1] += w * s[1]; acc[c4 * 4 + 2] += w * s[2]; acc[c4 * 4 + 3] += w * s[3]; } }
            bf16_t* dst = (bf16_t*)(ws + WS_WMIX) + (size_t)(n0 + lane) * DM + 512 + g * 128 + c0;
            u32x4 o0, o1; o0.x = pk2(acc[0], acc[1]); o0.y = pk2(acc[2], acc[3]); o0.z = pk2(acc[4], acc[5]); o0.w = pk2(acc[6], acc[7]);
            o1.x = pk2(acc[8], acc[9]); o1.y = pk2(acc[10], acc[11]); o1.z = pk2(acc[12], acc[13]); o1.w = pk2(acc[14], acc[15]);
            *(GAS u32x4*)dst = o0; *(GAS u32x4*)(dst + 8) = o1;
            LDS_WAIT(); asm volatile("" ::: "memory");
            continue; }
        r -= T_WF;
        if (r < T_ROPE) {
            const int idx = r * 64 + lane, pos = idx >> 3, j = idx & 7;
            const float invf = (float)exp(-(double)j * 1.640295422175541);
            const float ang = (float)pos * invf;
            const double rev = (double)ang * 0.15915494309189535; const float fr = (float)(rev - floor(rev));
            float* rp = (float*)(ws + WS_ROPE) + (size_t)pos * 16;
            rp[j] = __builtin_amdgcn_cosf(fr); rp[8 + j] = __builtin_amdgcn_sinf(fr);
            continue; }
        r -= T_ROPE;
        if (r < T_WR) {
            const int n = r >> 4, k = (r & 15) * 64 + lane;
            const float v = n < 4 ? P.w_rg[k * 4 + n] : (n < 36 ? P.w_re[k * 32 + (n - 4)] : 0.f);
            const unsigned hb = f2bf(v); const float lo = v - bf2f((unsigned short)hb);
            ((bf16_t*)(ws + WS_WRHI))[n * DM + k] = (bf16_t)hb; ((bf16_t*)(ws + WS_WRLO))[n * DM + k] = (bf16_t)f2bf(lo);
            continue; }
        r -= T_WR;
        if (r < I_WIN) { const int kb = r >> 6, nb = r & 63; transpose_item(P.w_in, 2048, kb * 64, nb * 32, (bf16_t*)(ws + WS_WIN), (size_t)nb * 32, DM, kb * 64, scr, lane); continue; }
        r -= I_WIN;
        { const int kb = r >> 5, nb = r & 31; transpose_item(P.w_out, DM, kb * 64, nb * 32, (bf16_t*)(ws + WS_WMIX), (size_t)nb * 32, DM, kb * 64, scr, lane); }
    }
}
__device__ __forceinline__ void p1_norm1(const Params& P, Frame& F) {
    const int gw = F.vcu * NWAVES + F.wave, NGW = F.G * NWAVES, lane = F.lane;
    unsigned char* ws = P.ws;
    const float* modp = (const float*)(ws + WS_MODP);
    for (int t = gw; t < 1536; t += NGW) {
        const int idx = t * 64 + lane, b = idx / 6144, n = idx - b * 6144;
        float v = P.b_ada[n];
#pragma unroll
        for (int kq = 0; kq < 8; ++kq) v += modp[(size_t)(kq * 16 + b) * 6144 + n];
        ((float*)(ws + WS_MODF))[idx] = v;
        if ((n >> 10) == 4) ((float*)(ws + WS_GM2))[b * DM + (n & 1023)] = P.norm2_g[n & 1023] * (1.f + v);
    }
    bf16_t* H1 = (bf16_t*)(ws + WS_H1);
    for (int g16 = gw; g16 < NTOK / 16; g16 += NGW) {
        const int row0 = g16 * 16, b = row0 >> 11;
        f32x4 gm[4], sh[4];
#pragma unroll
        for (int j = 0; j < 4; ++j) { const int col = 4 * lane + 256 * j;
            f32x4 s0 = *(const f32x4*)(P.b_ada + col), s1 = *(const f32x4*)(P.b_ada + 1024 + col);
#pragma unroll
            for (int kq = 0; kq < 8; ++kq) { const float* mp = modp + (size_t)(kq * 16 + b) * 6144 + col; s0 += *(const f32x4*)mp; s1 += *(const f32x4*)(mp + 1024); }
            sh[j] = s0; gm[j] = *(const f32x4*)(P.norm1_g + col) * (1.f + s1); }
        for (int rr = 0; rr < 16; ++rr) {
            const int row = row0 + rr;
            const GAS f32x4* xr = (const GAS f32x4*)(P.x + (size_t)row * DM) + lane;
            f32x4 v[4]; float s = 0.f;
#pragma unroll
            for (int j = 0; j < 4; ++j) { v[j] = xr[64 * j]; s += (v[j].x * v[j].x + v[j].y * v[j].y) + (v[j].z * v[j].z + v[j].w * v[j].w); }
            const float rstd = __builtin_amdgcn_rsqf(wave_sum(s) * (1.f / DM) + RMS_EPS);
            GAS u32x2* o8 = (GAS u32x2*)(H1 + (size_t)row * DM) + lane;
#pragma unroll
            for (int j = 0; j < 4; ++j) { const f32x4 hh = v[j] * rstd * gm[j] + sh[j]; u32x2 w; w.x = cvt_pk_bf16(hh.x, hh.y); w.y = cvt_pk_bf16(hh.z, hh.w); o8[64 * j] = w; }
        }
    }
}
__device__ __forceinline__ void p3_pooldiff(const Params& P, Frame& F) {
    const int gw = F.vcu * NWAVES + F.wave, NGW = F.G * NWAVES, lane = F.lane;
    const bf16_t* U = (const bf16_t*)(P.ws + WS_U); bf16_t* MIX = (bf16_t*)(P.ws + WS_MIXIN);
    const int g = lane >> 4, left = 1 << g, right = (1 << g) - 1;
    for (int t = gw; t < NTOK / 16; t += NGW) {
        const int row0 = t * 16, b = row0 >> 11, p0 = row0 & (SEQ - 1);
        const bf16_t* ub = U + (size_t)b * SEQ * 512 + lane * 8;
        float sum[8];
#pragma unroll
        for (int j = 0; j < 8; ++j) sum[j] = 0.f;
        { bf16x8 wv_[16];
#pragma unroll
          for (int q = 0; q < 16; ++q) { const int dj = q - 8, pj = p0 + dj; const bool in = dj >= -left && dj <= right && pj >= 0 && pj < SEQ;
              wv_[q] = in ? *(const bf16x8*)(ub + (size_t)pj * 512) : (bf16x8){0, 0, 0, 0, 0, 0, 0, 0}; }
#pragma unroll
          for (int q = 0; q < 16; ++q)
#pragma unroll
              for (int j = 0; j < 8; ++j) sum[j] += bf2f((unsigned short)wv_[q][j]); }
#pragma unroll
        for (int hb_ = 0; hb_ < 2; ++hb_) {
            bf16x8 cv[8], av[8], sv[8];
#pragma unroll
            for (int q = 0; q < 8; ++q) { const int p = p0 + hb_ * 8 + q, pa = p + 1 + right, ps = p - left;
                cv[q] = *(const bf16x8*)(ub + (size_t)p * 512);
                av[q] = pa < SEQ ? *(const bf16x8*)(ub + (size_t)pa * 512) : (bf16x8){0, 0, 0, 0, 0, 0, 0, 0};
                sv[q] = ps >= 0 ? *(const bf16x8*)(ub + (size_t)ps * 512) : (bf16x8){0, 0, 0, 0, 0, 0, 0, 0}; }
#pragma unroll
            for (int q = 0; q < 8; ++q) { const int p = p0 + hb_ * 8 + q;
                const int lo = p - left < 0 ? 0 : p - left, hi = p + right + 1 > SEQ ? SEQ : p + right + 1;
                const float inv = 1.f / (float)(hi - lo);
                float d[8];
#pragma unroll
                for (int j = 0; j < 8; ++j) d[j] = sum[j] * inv - bf2f((unsigned short)cv[q][j]);
                u32x4 w; w.x = cvt_pk_bf16(d[0], d[1]); w.y = cvt_pk_bf16(d[2], d[3]); w.z = cvt_pk_bf16(d[4], d[5]); w.w = cvt_pk_bf16(d[6], d[7]);
                *(u32x4*)(MIX + (size_t)(b * SEQ + p) * DM + 512 + lane * 8) = w;
#pragma unroll
                for (int j = 0; j < 8; ++j) sum[j] += bf2f((unsigned short)av[q][j]) - bf2f((unsigned short)sv[q][j]); }
        }
    }
}
#define ADD_DELTA(A, C, Dq) do { (A).x += __builtin_bit_cast(float, (Dq).x << 16); (A).y += __builtin_bit_cast(float, (Dq).x & 0xffff0000u); (A).z += __builtin_bit_cast(float, (Dq).y << 16); (A).w += __builtin_bit_cast(float, (Dq).y & 0xffff0000u); \
    (C).x += __builtin_bit_cast(float, (Dq).z << 16); (C).y += __builtin_bit_cast(float, (Dq).z & 0xffff0000u); (C).z += __builtin_bit_cast(float, (Dq).w << 16); (C).w += __builtin_bit_cast(float, (Dq).w & 0xffff0000u); } while (0)
__device__ __forceinline__ void p5_norm2_route(const Params& P, Frame& F, const int reps) {
    const int lane = F.lane, rr = lane & 15, kq = lane >> 4, kw = F.wave;
    unsigned char* ws = P.ws;
    LAS float* L_GM = (LAS float*)(F.lds); LAS float* L_SH = (LAS float*)(F.lds + 4096);
    LAS float* ssqp = (LAS float*)(F.lds + 8192);
    LAS float* L_BI = (LAS float*)(F.lds + 8192 + 1024);
    LAS float* lgp = (LAS float*)(F.lds + 12288);
    LAS int* rres = (LAS int*)(F.lds + 36864);
    LAS int* hist = (LAS int*)(F.lds + TB_HIST); LAS int* hb = (LAS int*)(F.lds + TB_HB);
    const float* gm2 = (const float*)(ws + WS_GM2); const float* modf = (const float*)(ws + WS_MODF);
    const bf16_t* wrhi = (const bf16_t*)(ws + WS_WRHI); const bf16_t* wrlo = (const bf16_t*)(ws + WS_WRLO);
    unsigned char* H2 = ws + WS_H2;
    int* rinfo = (int*)(ws + WS_RINFO); float* rw = (float*)(ws + WS_RW);
    gu32* cnt = (gu32*)(ws + WS_CTL) + CW_CNT;
    const int colb = kw * 128 + kq * 8;
    bf16x8 bhi[4][3], blo[4][3];
#pragma unroll
    for (int ks = 0; ks < 4; ++ks)
#pragma unroll
        for (int nb = 0; nb < 3; ++nb) { bhi[ks][nb] = *(const bf16x8*)(wrhi + (size_t)(nb * 16 + rr) * DM + colb + ks * 32); blo[ks][nb] = *(const bf16x8*)(wrlo + (size_t)(nb * 16 + rr) * DM + colb + ks * 32); }
    for (int rp_ = 0; rp_ < reps; ++rp_) { const bool dry = rp_ + 1 < reps;
    for (int blk = F.vcu; blk < NTOK / 128; blk += F.G) {
        const int b = (blk * 128) >> 11;
        if (F.tid < 256) { *(LAS f32x4*)(L_GM + 4 * F.tid) = *(const f32x4*)(gm2 + (size_t)b * DM + 4 * F.tid); *(LAS f32x4*)(L_SH + 4 * F.tid) = *(const f32x4*)(modf + (size_t)b * 6144 + 3 * 1024 + 4 * F.tid); }
        if (F.tid < 32) hist[F.tid] = 0;
        if (F.tid >= 64 && F.tid < 100) L_BI[F.tid - 64] = (F.tid < 68) ? P.b_rg[F.tid - 64] : P.b_re[F.tid - 68];
        const float* xbase = P.x + (size_t)(blk * 128 + rr) * DM + colb;
        const bf16_t* dbase = (const bf16_t*)(ws + WS_DELTA) + (size_t)(blk * 128 + rr) * DM + colb;
        f32x4 xa[4], xc[4]; u32x4 dl[4];
#pragma unroll
        for (int ks = 0; ks < 4; ++ks) { xa[ks] = *(const f32x4*)(xbase + ks * 32); xc[ks] = *(const f32x4*)(xbase + ks * 32 + 4); dl[ks] = *(const u32x4*)(dbase + ks * 32); }
        __syncthreads();
        for (int it = 0; it < 8; ++it) {
            const int row0 = blk * 128 + it * 16;
            float ssq = 0.f;
#pragma unroll
            for (int ks = 0; ks < 4; ++ks) { ADD_DELTA(xa[ks], xc[ks], dl[ks]); const f32x4 a = xa[ks], c = xc[ks]; ssq += (a.x * a.x + a.y * a.y) + (a.z * a.z + a.w * a.w) + (c.x * c.x + c.y * c.y) + (c.z * c.z + c.w * c.w); }
            ssq += __shfl_xor(ssq, 16); ssq += __shfl_xor(ssq, 32);
            if (kq == 0) ssqp[kw * 16 + rr] = ssq;
            __syncthreads();
            float tot = 0.f;
#pragma unroll
            for (int w = 0; w < 8; ++w) tot += ssqp[w * 16 + rr];
            const float rstd = __builtin_amdgcn_rsqf(tot * (1.f / DM) + RMS_EPS);
            f32x4 acc[3] = {{0.f, 0.f, 0.f, 0.f}, {0.f, 0.f, 0.f, 0.f}, {0.f, 0.f, 0.f, 0.f}};
            unsigned char* hrow = H2 + (size_t)(row0 + rr) * DM + colb;
            const float* xnext = xbase + (size_t)(it + 1) * 16 * DM; const bf16_t* dnext = dbase + (size_t)(it + 1) * 16 * DM;
#pragma unroll
            for (int ks = 0; ks < 4; ++ks) {
                const f32x4 g0 = *(const LAS f32x4*)(L_GM + colb + ks * 32), g1 = *(const LAS f32x4*)(L_GM + colb + ks * 32 + 4);
                const f32x4 s0 = *(const LAS f32x4*)(L_SH + colb + ks * 32), s1 = *(const LAS f32x4*)(L_SH + colb + ks * 32 + 4);
                const f32x4 h0 = xa[ks] * rstd * g0 + s0, h1 = xc[ks] * rstd * g1 + s1;
                if (it < 7) { xa[ks] = *(const f32x4*)(xnext + ks * 32); xc[ks] = *(const f32x4*)(xnext + ks * 32 + 4); dl[ks] = *(const u32x4*)(dnext + ks * 32); }
                u32x4 whi; whi.x = cvt_pk_bf16(h0.x, h0.y); whi.y = cvt_pk_bf16(h0.z, h0.w); whi.z = cvt_pk_bf16(h1.x, h1.y); whi.w = cvt_pk_bf16(h1.z, h1.w);
                f32x4 l0, l1;
                l0.x = h0.x - __builtin_bit_cast(float, whi.x << 16); l0.y = h0.y - __builtin_bit_cast(float, whi.x & 0xffff0000u);
                l0.z = h0.z - __builtin_bit_cast(float, whi.y << 16); l0.w = h0.w - __builtin_bit_cast(float, whi.y & 0xffff0000u);
                l1.x = h1.x - __builtin_bit_cast(float, whi.z << 16); l1.y = h1.y - __builtin_bit_cast(float, whi.z & 0xffff0000u);
                l1.z = h1.z - __builtin_bit_cast(float, whi.w << 16); l1.w = h1.w - __builtin_bit_cast(float, whi.w & 0xffff0000u);
                u32x4 wlo; wlo.x = cvt_pk_bf16(l0.x, l0.y); wlo.y = cvt_pk_bf16(l0.z, l0.w); wlo.z = cvt_pk_bf16(l1.x, l1.y); wlo.w = cvt_pk_bf16(l1.z, l1.w);
                { u32x2 w8; w8.x = pk4_fp8(h0.x, h0.y, h0.z, h0.w); w8.y = pk4_fp8(h1.x, h1.y, h1.z, h1.w); *(u32x2*)(hrow + ks * 32) = w8; }
                const bf16x8 ahi = __builtin_bit_cast(bf16x8, whi), alo = __builtin_bit_cast(bf16x8, wlo);
#pragma unroll
                for (int nb = 0; nb < 3; ++nb) {
                    acc[nb] = __builtin_amdgcn_mfma_f32_16x16x32_bf16(ahi, bhi[ks][nb], acc[nb], 0, 0, 0);
                    acc[nb] = __builtin_amdgcn_mfma_f32_16x16x32_bf16(alo, bhi[ks][nb], acc[nb], 0, 0, 0);
                    acc[nb] = __builtin_amdgcn_mfma_f32_16x16x32_bf16(ahi, blo[ks][nb], acc[nb], 0, 0, 0);
                }
            }
            LAS float* lgw = lgp + kw * 768;
#pragma unroll
            for (int nb = 0; nb < 3; ++nb)
#pragma unroll
                for (int r = 0; r < 4; ++r) lgw[(kq * 4 + r) * 48 + nb * 16 + rr] = acc[nb][r];
            __syncthreads();
            if (kw == it && lane < 16) {
                const LAS float* L = lgp + lane * 48;
#define LG(j) (((L[(j)] + L[768 + (j)]) + (L[1536 + (j)] + L[2304 + (j)])) + ((L[3072 + (j)] + L[3840 + (j)]) + (L[4608 + (j)] + L[5376 + (j)])))
                float gl[4]; int gs = 0; float gmx;
#pragma unroll
                for (int j = 0; j < 4; ++j) gl[j] = LG(j) + L_BI[j];
                gmx = gl[0];
#pragma unroll
                for (int j = 1; j < 4; ++j) if (gl[j] > gmx) { gmx = gl[j]; gs = j; }
                float gden = 0.f;
#pragma unroll
                for (int j = 0; j < 4; ++j) gden += __expf(gl[j] - gmx);
                const float gpv = 1.f / gden;
                float el[8];
#pragma unroll
                for (int j = 0; j < 8; ++j) el[j] = LG(4 + gs * 8 + j) + L_BI[4 + gs * 8 + j];
#undef LG
                int i0 = 0; float m0 = el[0];
#pragma unroll
                for (int j = 1; j < 8; ++j) if (el[j] > m0) { m0 = el[j]; i0 = j; }
                int i1 = -1; float m1 = -3.0e38f;
#pragma unroll
                for (int j = 0; j < 8; ++j) if (j != i0 && el[j] > m1) { m1 = el[j]; i1 = j; }
                const float tt = __expf(m1 - m0), den = 1.f / (1.f + tt);
                const int e0 = gs * 8 + i0, e1 = gs * 8 + i1;
                int lr0 = 0, lr1 = 0;
                if (!dry) { lr0 = atomicAdd((int*)(hist + e0), 1); lr1 = atomicAdd((int*)(hist + e1), 1); }
                LAS int* rp = rres + (it * 16 + lane) * 6;
                rp[0] = e0; rp[1] = e1; rp[2] = __builtin_bit_cast(int, gpv * den); rp[3] = __builtin_bit_cast(int, gpv * tt * den); rp[4] = lr0; rp[5] = lr1;
            }
        }
        __syncthreads();
        if (F.tid < 32 && !dry) { const int hc = hist[F.tid]; hb[F.tid] = hc ? (int)__hip_atomic_fetch_add(cnt + 64 * F.tid, (unsigned)hc, __ATOMIC_RELAXED, __HIP_MEMORY_SCOPE_AGENT) : 0; }
        __syncthreads();
        if (F.tid < 128 && !dry) { const LAS int* rp = rres + F.tid * 6; const int tok = blk * 128 + F.tid;
            const int e0 = rp[0], e1 = rp[1];
            const int p0 = e0 * ECAP + hb[e0] + rp[4], p1 = e1 * ECAP + hb[e1] + rp[5];
            rinfo[p0] = tok * 2; rw[p0] = __builtin_bit_cast(float, rp[2]); rinfo[p1] = tok * 2 + 1; rw[p1] = __builtin_bit_cast(float, rp[3]); }
        __syncthreads();
    }
    }
}
__device__ __forceinline__ int p6_tables(const Params& P, Frame& F) {
    LAS int* rt_e = (LAS int*)(F.lds + TB_RTE); LAS int* rtb = (LAS int*)(F.lds + TB_RTB); LAS int* cs = (LAS int*)(F.lds + TB_CNT);
    gu32* cnt = (gu32*)(P.ws + WS_CTL) + CW_CNT;
    if (F.tid < 32) cs[F.tid] = (int)__hip_atomic_load(cnt + 64 * F.tid, __ATOMIC_RELAXED, __HIP_MEMORY_SCOPE_AGENT);
    __syncthreads();
    if (F.tid == 0) { int a = 0; for (int e = 0; e < NEXP; ++e) { rtb[e] = a; a += (cs[e] + 255) >> 8; } rtb[NEXP] = a; }
    __syncthreads();
    const int nrt = rtb[NEXP];
    if (F.tid < nrt && F.tid < 320) { int e = 0; for (int j = 1; j < NEXP; ++j) e += (rtb[j] <= F.tid) ? 1 : 0; rt_e[F.tid] = e; }
    __syncthreads();
    return nrt;
}
__device__ __forceinline__ void p6_rowlists(const Params& P, Frame& F, const gm::MoeOrder& S) {
    LAS int* tokrow = (LAS int*)(F.lds + TB_TOK); LAS float* wrow = (LAS float*)(F.lds + TB_W); LAS int* cs = (LAS int*)(F.lds + TB_CNT);
    const int* rinfo = (const int*)(P.ws + WS_RINFO); const float* rw = (const float*)(P.ws + WS_RW);
    if (F.tid < 256) {
        int ti[MAXU]; float tw[MAXU]; bool have[MAXU];
#pragma unroll
        for (int li = 0; li < MAXU; ++li) { gm::Unit u; have[li] = S.next(li, u); ti[li] = -1; tw[li] = 0.f;
            if (have[li]) { const int idx = u.mt * 256 + F.tid; if (idx < cs[u.e]) { ti[li] = rinfo[(size_t)u.e * ECAP + idx]; tw[li] = rw[(size_t)u.e * ECAP + idx]; } } }
#pragma unroll
        for (int li = 0; li < MAXU; ++li) if (have[li]) { tokrow[li * 256 + F.tid] = ti[li]; wrow[li * 256 + F.tid] = tw[li]; }
    }
    __syncthreads();
}
__device__ __forceinline__ void p8_final(const Params& P, Frame& F, float* dst) {
    const int gw = F.vcu * NWAVES + F.wave, NGW = F.G * NWAVES, lane = F.lane;
    const unsigned char* YS = P.ws + WS_YS; const float* modf = (const float*)(P.ws + WS_MODF);
    f32x4 fg[4];
#pragma unroll
    for (int j = 0; j < 4; ++j) fg[j] = *(const f32x4*)(P.final_g + 4 * lane + 256 * j);
    for (int g16 = gw; g16 < NTOK / 16; g16 += NGW) {
        const int row0 = g16 * 16, b = row0 >> 11;
        f32x4 g2[4];
#pragma unroll
        for (int j = 0; j < 4; ++j) g2[j] = *(const f32x4*)(modf + (size_t)b * 6144 + 5 * 1024 + 4 * lane + 256 * j);
        for (int rr = 0; rr < 16; ++rr) {
            const int row = row0 + rr;
            const GAS f32x4* xr = (const GAS f32x4*)(P.x + (size_t)row * DM) + lane; const GAS u32x2* dr = (const GAS u32x2*)((const bf16_t*)(P.ws + WS_DELTA) + (size_t)row * DM) + lane;
            const GAS unsigned* ya = (const GAS unsigned*)(YS + (size_t)(2 * row) * DM) + lane; const GAS unsigned* yb = (const GAS unsigned*)(YS + (size_t)(2 * row + 1) * DM) + lane;
            f32x4 v[4]; float s = 0.f;
#pragma unroll
            for (int j = 0; j < 4; ++j) { f32x4 xv = xr[64 * j]; const u32x2 dq = dr[64 * j]; const unsigned a = ya[64 * j], c = yb[64 * j];
                xv.x += __builtin_bit_cast(float, dq.x << 16); xv.y += __builtin_bit_cast(float, dq.x & 0xffff0000u); xv.z += __builtin_bit_cast(float, dq.y << 16); xv.w += __builtin_bit_cast(float, dq.y & 0xffff0000u);
                const f32x2 a0 = __builtin_amdgcn_cvt_pk_f32_fp8((int)a, false), a1 = __builtin_amdgcn_cvt_pk_f32_fp8((int)a, true), c0 = __builtin_amdgcn_cvt_pk_f32_fp8((int)c, false), c1 = __builtin_amdgcn_cvt_pk_f32_fp8((int)c, true);
                f32x4 y; y.x = a0.x + c0.x; y.y = a0.y + c0.y; y.z = a1.x + c1.x; y.w = a1.y + c1.y;
                v[j] = xv + g2[j] * (y * 0.0625f); s += (v[j].x * v[j].x + v[j].y * v[j].y) + (v[j].z * v[j].z + v[j].w * v[j].w); }
            const float rstd = __builtin_amdgcn_rsqf(wave_sum(s) * (1.f / DM) + RMS_EPS);
#pragma unroll
            for (int j = 0; j < 4; ++j) ((GAS f32x4*)(dst + (size_t)row * DM) + lane)[64 * j] = v[j] * rstd * fg[j];
        }
    }
}

__device__ __forceinline__ void ph2_inproj(const Params& P, Frame& F) {
    unsigned char* ws = P.ws;
    gm::DenseOrder S; S.init(ws + WS_H1, ws + WS_WIN, NTOK, 2048, DM, F.G, (int)blockIdx.x);
    gm::EpiQKVU E{(bf16_t*)(ws + WS_Q), (bf16_t*)(ws + WS_K), (bf16_t*)(ws + WS_V), (bf16_t*)(ws + WS_U), (const float*)(ws + WS_ROPE)};
    gm::gemm_phase<gm::EpiQKVU, gm::DenseOrder>(F.lds, S, E);
}
__device__ __forceinline__ void ph3_mixers(const Params& P, Frame& F, char* lds_gen, const int reps) {
    unsigned char* ws = P.ws;
    p3_pooldiff(P, F);
    const float lam = __expf(wave_sum(P.lq1[F.lane] * P.lk1[F.lane])) - __expf(wave_sum(P.lq2[F.lane] * P.lk2[F.lane])) + 0.2f;
    att::Weave wv{P.w_gate, P.w_up, P.w_down, ws + WS_WGU, ws + WS_WD, 0, 0, -1};
    { const int per = (6144 + F.G - 1) / F.G; wv.next = F.vcu * per; wv.end = wv.next + per < 6144 ? wv.next + per : 6144; if (wv.next > 6144) wv.next = 6144; }
    const int rounds = (NB * 4 * 16 + F.G - 1) / F.G;
    for (int ii = 0; ii < reps * rounds; ++ii) {
        const int i = ii % rounds;
        const int U = i * F.G + F.vcu; if (U >= NB * 4 * 16) continue;
        const int bh = U >> 4, qb = U & 15;
        att::attn_unit((const bf16_t*)(ws + WS_Q), (const bf16_t*)(ws + WS_K), (const bf16_t*)(ws + WS_V), (bf16_t*)(ws + WS_MIXIN), bh >> 2, bh & 3, qb, lam, P.subln_g, lds_gen, F.lds, wv);
    }
    while (wv.pend >= 0 || wv.next < wv.end) { asm volatile("s_waitcnt vmcnt(0)" ::: "memory"); att::weave_step(wv, lds_gen, F.lds, F.wave, F.lane); }
}
__device__ __forceinline__ void ph4_outproj(const Params& P, Frame& F) {
    unsigned char* ws = P.ws;
    gm::DenseOrder S; S.init(ws + WS_MIXIN, ws + WS_WMIX, NTOK, DM, DM, F.G, (int)blockIdx.x);
    gm::EpiMix E{(bf16_t*)(ws + WS_DELTA), (const float*)(ws + WS_MODF) + 2 * 1024};
    gm::gemm_phase<gm::EpiMix, gm::DenseOrder>(F.lds, S, E);
}
__device__ __forceinline__ void ph6_gateup(const Params& P, Frame& F, gm::MoeOrder S) {
    unsigned char* ws = P.ws;
    S.KB = DM; S.A = (const char*)(ws + WS_H2); S.Bt = (const char*)(ws + WS_WGU); S.bexp = (size_t)DM * DM; S.gather = true;
    gm::EpiGateUp E{ws + WS_HID};
    gm::gemm_phase<gm::EpiGateUp, gm::MoeOrder, true>(F.lds, S, E);
}
__device__ __forceinline__ void ph7_down(const Params& P, Frame& F, gm::MoeOrder S) {
    unsigned char* ws = P.ws;
    S.KB = DEXP; S.A = (const char*)(ws + WS_HID); S.Bt = (const char*)(ws + WS_WD); S.bexp = (size_t)DM * DEXP; S.gather = false;
    gm::EpiDown E{ws + WS_YS, (const LAS int*)(F.lds + TB_TOK), (const LAS float*)(F.lds + TB_W)};
    gm::gemm_phase<gm::EpiDown, gm::MoeOrder, true>(F.lds, S, E);
}

__global__ void __launch_bounds__(NTHR, 2) fwd_kernel(Params P) {
    extern __shared__ __attribute__((aligned(16))) unsigned char lds_raw[];
    Frame F;
    F.lds = (LAS unsigned char*)lds_raw;
    F.tid = threadIdx.x; F.lane = F.tid & 63; F.wave = __builtin_amdgcn_readfirstlane(F.tid >> 6);
    F.G = gridDim.x; { const int bx = blockIdx.x; F.vcu = (F.G % 8 == 0) ? (bx % 8) * (F.G / 8) + bx / 8 : bx; }
    unsigned char* ws = P.ws;
    gu32* ctl = (gu32*)(ws + WS_CTL);
    volatile LAS unsigned* MISC = (volatile LAS unsigned*)(F.lds + MISC_OFF);
    for (int u = F.tid; u < (LDS_BYTES - RING_BYTES) / 4; u += NTHR) ((LAS unsigned*)(F.lds + RING_BYTES))[u] = 0u;
    __syncthreads();
    const int lo = (int)(P.ph & 0xff), hi = (int)((P.ph >> 8) & 0xff), li = (int)((P.ph >> 16) & 0xff);
    XcdBarrier bar; bar.bar = (unsigned*)(ctl + CW_BAR) + li * XCD_BAR_WORDS; bar.x = 0; bar.st = nullptr;
    if (N_LAUNCHES != N_PHASES) bar = xcd_barrier_post((unsigned*)(ctl + CW_BAR) + li * XCD_BAR_WORDS, MISC + 8);
#define IN(k) (lo <= (k) && (k) < hi)
#define GRID_BAR(k) do { if (IN(k) && IN((k) + 1)) xcd_barrier(bar); } while (0)
#define RUN(k, call) do { if (IN(k)) { { constexpr int rep = 0; (void)rep; call; } if (PROBE_PHASE == (k)) { xcd_barrier(bar); { constexpr int rep = 1; (void)rep; call; } } GRID_BAR(k); } } while (0)

    RUN(0, p0_prologue(P, F));
    RUN(1, p1_norm1(P, F));
    RUN(2, ph2_inproj(P, F));
    if (IN(3)) { ph3_mixers(P, F, (char*)lds_raw, PROBE_PHASE == 3 ? 2 : 1); GRID_BAR(3); }
    RUN(4, ph4_outproj(P, F));
    if (IN(5)) { p5_norm2_route(P, F, PROBE_PHASE == 5 ? 2 : 1); GRID_BAR(5); }
    if (IN(6) || IN(7)) {
        const int nrt = p6_tables(P, F);
        gm::MoeOrder S; S.rt_e = (const LAS int*)(F.lds + TB_RTE); S.rtbase = (const LAS int*)(F.lds + TB_RTB); S.tokrow = (const LAS int*)(F.lds + TB_TOK);
        S.nunits = 4 * nrt; S.G = F.G; S.c = (int)blockIdx.x; S.KB = 0; S.A = nullptr; S.Bt = nullptr; S.bexp = 0; S.gather = false;
        p6_rowlists(P, F, S);
        RUN(6, ph6_gateup(P, F, S));
        RUN(7, ph7_down(P, F, S));
    }
    RUN(8, p8_final(P, F, (rep == 0 && PROBE_PHASE == 8) ? (float*)(ws + WS_A) : P.out));
#undef IN
#undef GRID_BAR
#undef RUN
}

extern "C" void kernel_launch(void* const* d_in, const int* in_sizes, int n_in, void* d_out, int out_size, void* d_ws, size_t ws_size, hipStream_t stream) {
    static int grid = 0;
    if (grid == 0) {
        if (n_in != 23 || in_sizes[0] != NTOK * DM || out_size != NTOK * DM || ws_size < WS_END) { fprintf(stderr, "kernel_launch: unexpected shapes (n_in %d, in0 %d, out %d, ws %zu)\n", n_in, n_in > 0 ? in_sizes[0] : -1, out_size, ws_size); grid = -1; return; }
        int dev = 0, cus = 0, per_cu = 0;
        if (hipGetDevice(&dev) != hipSuccess || hipDeviceGetAttribute(&cus, hipDeviceAttributeMultiprocessorCount, dev) != hipSuccess) { grid = -1; return; }
        if (hipFuncSetAttribute((const void*)fwd_kernel, hipFuncAttributeMaxDynamicSharedMemorySize, LDS_BYTES) != hipSuccess) { fprintf(stderr, "kernel_launch: hipFuncSetAttribute failed\n"); grid = -1; return; }
        if (hipOccupancyMaxActiveBlocksPerMultiprocessor(&per_cu, (const void*)fwd_kernel, NTHR, LDS_BYTES) != hipSuccess || per_cu < 1) fprintf(stderr, "kernel_launch: occupancy query reports %d\n", per_cu);
        (void)hipGetLastError();
        grid = cus;
    }
    if (grid < 0) return;
    if (hipMemsetAsync((char*)d_ws + WS_CTL, 0, CTL_ZERO_BYTES, stream) != hipSuccess) return;
    Params p{};
    const float** pp = (const float**)&p;
    for (int i = 0; i < 23; ++i) pp[i] = (const float*)d_in[i];
    p.out = (float*)d_out; p.ws = (unsigned char*)d_ws;
    if (N_LAUNCHES == 1) { p.ph = 0 | ((long long)N_PHASES << 8); hipLaunchKernelGGL(fwd_kernel, dim3(grid), dim3(NTHR), LDS_BYTES, stream, p); }
    else for (int k = 0; k < N_PHASES; ++k) {
        p.ph = (long long)k | ((long long)(k + 1) << 8); hipLaunchKernelGGL(fwd_kernel, dim3(grid), dim3(NTHR), LDS_BYTES, stream, p); }
}
```

```cpp
#include <hip/hip_runtime.h>
#include <cstdio>
#include <cstdint>

#ifndef MK_N_LAUNCHES
#define MK_N_LAUNCHES 1
#endif
#ifndef PROBE_PHASE
#define PROBE_PHASE -1
#endif
constexpr int N_PHASES = 9;
constexpr int N_LAUNCHES = MK_N_LAUNCHES;

#define GAS __attribute__((address_space(1)))
#define LAS __attribute__((address_space(3)))
typedef unsigned short bf16_t;
typedef short bf16x8 __attribute__((ext_vector_type(8)));
typedef short s16x4 __attribute__((ext_vector_type(4)));
typedef float f32x2 __attribute__((ext_vector_type(2)));
typedef float f32x4 __attribute__((ext_vector_type(4)));
typedef float f32x16 __attribute__((ext_vector_type(16)));
typedef unsigned u32x2 __attribute__((ext_vector_type(2)));
typedef unsigned u32x4 __attribute__((ext_vector_type(4)));
typedef GAS unsigned gu32;
typedef int i32x8 __attribute__((ext_vector_type(8)));
typedef int i32x4 __attribute__((ext_vector_type(4)));

constexpr int DM = 1024, NB = 16, SEQ = 2048, NTOK = NB * SEQ;
constexpr int NEXP = 32, DEXP = 512, ECAP = NTOK;
constexpr int NWAVES = 8, NTHR = NWAVES * 64;
constexpr float RMS_EPS = 1e-6f;
constexpr int MAXU = 6;

constexpr size_t MiB = 1u << 20;
constexpr size_t WS_CTL = 0, CTL_ZERO_BYTES = 1 * MiB;
constexpr size_t WS_MODP = 1 * MiB;
constexpr size_t WS_MODF = 4 * MiB;
constexpr size_t WS_GM2  = WS_MODF + 384 * 1024;
constexpr size_t WS_ROPE = WS_GM2 + 64 * 1024;
constexpr size_t WS_WRHI = WS_ROPE + 128 * 1024;
constexpr size_t WS_WRLO = WS_WRHI + 96 * 1024;
constexpr size_t WS_RINFO = 5 * MiB;
constexpr size_t WS_RW    = 9 * MiB;
constexpr size_t WS_WIN  = 13 * MiB;
constexpr size_t WS_WMIX = 17 * MiB;
constexpr size_t WS_WGU  = 19 * MiB;
constexpr size_t WS_WD   = 83 * MiB;
constexpr size_t WS_A    = 115 * MiB;
constexpr size_t WS_H1   = WS_A;
constexpr size_t WS_HID  = WS_A;
constexpr size_t WS_MIXIN = WS_A + 72 * MiB;
constexpr size_t WS_H2   = WS_A + 72 * MiB;
constexpr size_t WS_Q    = 251 * MiB;
constexpr size_t WS_K    = WS_Q + 32 * MiB;
constexpr size_t WS_V    = WS_K + 32 * MiB;
constexpr size_t WS_U    = WS_V + 32 * MiB;
constexpr size_t WS_X1 = WS_V;
constexpr size_t WS_YS   = WS_Q;
constexpr size_t WS_END  = 379 * MiB;
constexpr int CW_BAR = 4096;
constexpr int CW_CNT = 16384;

constexpr int RING_BYTES = 139264;
constexpr int TB_TOK = RING_BYTES;
constexpr int TB_W   = TB_TOK + MAXU * 1024;
constexpr int TB_RTE = TB_W + MAXU * 1024;
constexpr int TB_RTB = TB_RTE + 1280;
constexpr int TB_CNT = TB_RTB + 160;
constexpr int TB_HIST = TB_CNT + 128;
constexpr int TB_HB  = TB_HIST + 128;
constexpr int MISC_OFF = TB_HB + 128;
constexpr int LDS_BYTES = MISC_OFF + 128;
static_assert(LDS_BYTES <= 163840 && (MISC_OFF % 16) == 0, "LDS map");

#define LDS_WAIT() asm volatile("s_waitcnt lgkmcnt(0)" ::: "memory")
#define VM_WAIT() asm volatile("s_waitcnt vmcnt(0)" ::: "memory")
#define SBAR() __builtin_amdgcn_sched_barrier(0)
__device__ __forceinline__ unsigned f2bf(float f) { unsigned u = __builtin_bit_cast(unsigned, f); return (u + 0x7fffu + ((u >> 16) & 1u)) >> 16; }
__device__ __forceinline__ unsigned pk2(float lo, float hi) { return f2bf(lo) | (f2bf(hi) << 16); }
__device__ __forceinline__ float bf2f(unsigned short b) { return __builtin_bit_cast(float, (unsigned)b << 16); }
__device__ __forceinline__ unsigned cvt_pk_bf16(float lo, float hi) { unsigned r; asm volatile("v_cvt_pk_bf16_f32 %0, %1, %2" : "=v"(r) : "v"(lo), "v"(hi)); return r; }
__device__ __forceinline__ unsigned pk4_fp8(float a, float b, float c, float d) { int w = 0; w = __builtin_amdgcn_cvt_pk_fp8_f32(a, b, w, false); w = __builtin_amdgcn_cvt_pk_fp8_f32(c, d, w, true); return (unsigned)w; }
__device__ __forceinline__ float wave_sum(float v) {
#pragma unroll
    for (int o = 1; o < 64; o <<= 1) v += __shfl_xor(v, o);
    return v;
}

#define XB_TMO      128
#define XB_XCNT(j)  (256  + 64 * (j))
#define XB_XSUB(j)  (1280 + 64 * (j))
#define XB_XGEN(j)  (2304 + 64 * (j))
#define XB_TOP      3328
#define XB_TOPGEN   3392
#define XCD_BAR_WORDS 3456
#define XB_SPIN_CAP (1u << 18)
__device__ __forceinline__ unsigned xb_ld(unsigned* p)              { return __hip_atomic_load(p, __ATOMIC_RELAXED, __HIP_MEMORY_SCOPE_AGENT); }
__device__ __forceinline__ unsigned xb_add(unsigned* p, unsigned v) { return __hip_atomic_fetch_add(p, v, __ATOMIC_RELAXED, __HIP_MEMORY_SCOPE_AGENT); }
__device__ __forceinline__ unsigned xb_xcc_id() { return (unsigned)__builtin_amdgcn_s_getreg((3 << 11) | 20) & 0xFu; }
#define XB_SPIN(cond, bar) do { unsigned _sp = 0; while (cond) { __builtin_amdgcn_s_sleep(1); \
    if ((++_sp & 255u) == 0u) { if (xb_ld(&(bar)[XB_TMO])) break; if (_sp > XB_SPIN_CAP) { atomicAdd(&(bar)[XB_TMO], 1u); break; } } } } while (0)
struct XcdBarrier { unsigned* bar; unsigned x; volatile LAS unsigned* st; };
__device__ __forceinline__ XcdBarrier xcd_barrier_post(unsigned* bar, volatile LAS unsigned* st) {
    XcdBarrier b; b.bar = bar; b.x = xb_xcc_id(); b.st = st;
    if (threadIdx.x == 0) (void)xb_add(&bar[XB_XCNT(b.x)], 1u);
    return b;
}
__device__ __forceinline__ void xcd_barrier_complete(unsigned* bar, unsigned x, unsigned& nloc, unsigned& nx) {
    const unsigned G = gridDim.x * gridDim.y * gridDim.z;
    unsigned sum, cnt, mine, sp = 0u;
    for (;;) {
        sum = 0u; cnt = 0u; mine = 0u;
#pragma unroll
        for (unsigned j = 0; j < 16; ++j) { const unsigned c = xb_ld(&bar[XB_XCNT(j)]); sum += c; cnt += (c > 0u) ? 1u : 0u; mine = (j == x) ? c : mine; }
        if (sum == G) break;
        __builtin_amdgcn_s_sleep(1);
        if ((++sp & 255u) == 0u) { if (xb_ld(&bar[XB_TMO])) break; if (sp > XB_SPIN_CAP) { atomicAdd(&bar[XB_TMO], 1u); break; } }
    }
    nloc = mine > 0u ? mine : 1u; nx = cnt > 0u ? cnt : 1u;
}
__device__ __forceinline__ void xcd_barrier(const XcdBarrier& b) {
    asm volatile("s_waitcnt vmcnt(0)" ::: "memory");
    __syncthreads();
    if (threadIdx.x == 0) {
        unsigned* bar = b.bar;
        __builtin_amdgcn_s_waitcnt(0);
        unsigned nloc = b.st[0], nx = b.st[1];
        if (nloc == 0u) { xcd_barrier_complete(bar, b.x, nloc, nx); b.st[0] = nloc; b.st[1] = nx; }
        const unsigned old = xb_add(&bar[XB_XSUB(b.x)], 1u);
        const unsigned gen = old / nloc;
        if (old + 1u == (gen + 1u) * nloc) {
            __builtin_amdgcn_fence(__ATOMIC_RELEASE, "agent");
            asm volatile("s_waitcnt vmcnt(0)" ::: "memory");
            const unsigned og = xb_add(&bar[XB_TOP], 1u);
            const unsigned tg = og / nx;
            if (og + 1u == (tg + 1u) * nx) xb_add(&bar[XB_TOPGEN], 1u);
            else XB_SPIN(xb_ld(&bar[XB_TOPGEN]) == tg, bar);
            __builtin_amdgcn_fence(__ATOMIC_ACQUIRE, "agent");
            xb_add(&bar[XB_XGEN(b.x)], 1u);
            asm volatile("s_waitcnt vmcnt(0)" ::: "memory");
        } else {
            XB_SPIN(xb_ld(&bar[XB_XGEN(b.x)]) == gen, bar);
            __builtin_amdgcn_fence(__ATOMIC_ACQUIRE, "agent");
            asm volatile("s_waitcnt vmcnt(0)" ::: "memory");
        }
    }
    __syncthreads();
}

namespace gm {
constexpr int BM = 256, BK = 64, HALF = 128, HTB = HALF * BK * 2, STAGE_BYTES = 8 * HTB, NXCD = 8, WGM = 16;
__device__ __forceinline__ int lds_byte(int r, int c) { const int st = (r >> 4) * 2 + (c >> 5), rr = r & 15, cc = c & 31, ob = rr * 64 + cc * 2; return st * 1024 + (ob ^ (((ob >> 9) & 1) << 5)); }
__device__ __forceinline__ void stage_rc(int b, int& R, int& C) { const int st = b / 1024, sb = b % 1024, swz = sb ^ (((sb >> 9) & 1) << 5); R = (st >> 1) * 16 + swz / 64; C = (st & 1) * 32 + (swz % 64) / 2; }
__device__ __forceinline__ int perm32(int rho) { const int n = rho >> 4, i = rho & 15; return 8 * (i >> 2) + 4 * n + (i & 3); }
struct Unit { int pm, pn, e, mt, li; };

struct DenseOrder {
    int nM, nN, nwg, G, c, KB; const char* A; const char* Bt;
    __device__ __forceinline__ void init(const void* A_, const void* Bt_, int M, int N, int K_, int G_, int c_) { A = (const char*)A_; Bt = (const char*)Bt_; nM = M / BM; nN = N / BM; nwg = nM * nN; G = G_; c = c_; KB = K_ * 2; }
    __device__ __forceinline__ bool next(int i, Unit& u) const {
        const long L = (long)i * G + c; if (L >= nwg) return false;
        int wgid = (int)L; { const int q = nwg / NXCD, r = nwg % NXCD, xcd = wgid % NXCD, off = wgid / NXCD; wgid = (xcd < r ? xcd * (q + 1) : r * (q + 1) + (xcd - r) * q) + off; }
        const int nig = WGM * nN, gid = wgid / nig, fm = gid * WGM, gsz = (nM - fm) < WGM ? (nM - fm) : WGM;
        u.pm = fm + ((wgid % nig) % gsz); u.pn = (wgid % nig) / gsz; u.e = 0; u.mt = 0; u.li = i; return true;
    }
    __device__ __forceinline__ const char* abase() const { return A; }
    __device__ __forceinline__ unsigned aoff(const Unit& u, int r) const { return (unsigned)(u.pm * BM + r) * (unsigned)KB; }
    __device__ __forceinline__ const char* bptr(const Unit& u) const { return Bt + (size_t)u.pn * BM * KB; }
};
struct MoeOrder {
    const LAS int* rt_e; const LAS int* rtbase; const LAS int* tokrow; int nunits, G, c, KB; const char* A; const char* Bt; size_t bexp; bool gather;
    __device__ __forceinline__ bool next(int i, Unit& u) const {
        const long L = (long)i * G + c; if (L >= nunits) return false;
        int wgid = (int)L; { const int q = nunits / NXCD, r = nunits % NXCD, xcd = wgid % NXCD, off = wgid / NXCD; wgid = (xcd < r ? xcd * (q + 1) : r * (q + 1) + (xcd - r) * q) + off; }
        const int rt = wgid >> 2; const int e = __builtin_amdgcn_readfirstlane(rt_e[rt]); const int rb = __builtin_amdgcn_readfirstlane(rtbase[e]);
        u.pm = rt; u.pn = wgid & 3; u.e = e; u.mt = rt - rb; u.li = i; return true;
    }
    __device__ __forceinline__ const char* abase() const { return A; }
    __device__ __forceinline__ unsigned aoff(const Unit& u, int r) const {
        if (gather) { int t = tokrow[u.li * 256 + r] >> 1; t = t < 0 ? 0 : t; return (unsigned)t * (unsigned)KB; }
        return (unsigned)(u.pm * BM + r) * (unsigned)KB;
    }
    __device__ __forceinline__ const char* bptr(const Unit& u) const { return Bt + (size_t)u.e * bexp + (size_t)u.pn * BM * KB; }
};

template <class Epi, class Sched, bool F8 = false>
__device__ __forceinline__ void gemm_phase(LAS unsigned char* lds, const Sched& S, const Epi& E) {
    const int tid = threadIdx.x, wid = __builtin_amdgcn_readfirstlane(tid >> 6), lane = tid & 63, wr = wid >> 2, wc = wid & 3, fr = lane & 15, fq = lane >> 4;
    const int KB = S.KB, nt = KB / (BK * 2);
    int RA[2]; unsigned CA2[2], voffB[2];
#pragma unroll
    for (int i = 0; i < 2; ++i) { int R, C; stage_rc(tid * 16 + i * 8192, R, C); const int Rb = (R & ~31) + perm32(R & 31);
        RA[i] = R; CA2[i] = (unsigned)C * 2u; voffB[i] = (unsigned)(Rb * KB + C * 2); }
    const unsigned kstep = (unsigned)(BK * 2);
    const size_t hstep = (size_t)HALF * KB;
    const unsigned ldsw = (unsigned)wid * 1024u;
    const int aoff = lds_byte(wr * 64 + fr, fq * 8), boff = lds_byte(wc * 32 + fr, fq * 8);
#define GM_SA(b, h) (((b) * 2 + (h)) * HTB)
#define GM_SB(b, h) ((4 + (b) * 2 + (h)) * HTB)
#define GM_STAGE_B(bufoff, gbase) do { _Pragma("unroll") for (int _i = 0; _i < 2; ++_i) \
        __builtin_amdgcn_global_load_lds((const unsigned*)((const char*)(gbase) + voffB[_i]), (LAS unsigned*)(lds + (bufoff) + ldsw + _i * 8192), 16, 0, 0); } while (0)
#define GM_STAGE_A(bufoff, offs, koff) do { _Pragma("unroll") for (int _i = 0; _i < 2; ++_i) \
        __builtin_amdgcn_global_load_lds((const unsigned*)((Ab + (koff)) + (offs)[_i]), (LAS unsigned*)(lds + (bufoff) + ldsw + _i * 8192), 16, 0, 0); } while (0)
#define GM_LD8(p) __builtin_shufflevector(*(const LAS i32x4*)(p), *(const LAS i32x4*)((p) + 1024), 0, 1, 2, 3, 4, 5, 6, 7)
#define GM_LDA(dst, b, h) do { _Pragma("unroll") for (int m = 0; m < 4; ++m) { if constexpr (F8) dst##8[m] = GM_LD8(lds + GM_SA(b, h) + aoff + m * 2048); \
        else { _Pragma("unroll") for (int k = 0; k < 2; ++k) dst[m][k] = *(const LAS bf16x8*)(lds + GM_SA(b, h) + aoff + m * 2048 + k * 1024); } } } while (0)
#define GM_LDB(dst, b, h) do { _Pragma("unroll") for (int n = 0; n < 2; ++n) { if constexpr (F8) dst##8[n] = GM_LD8(lds + GM_SB(b, h) + boff + n * 2048); \
        else { _Pragma("unroll") for (int k = 0; k < 2; ++k) dst[n][k] = *(const LAS bf16x8*)(lds + GM_SB(b, h) + boff + n * 2048 + k * 1024); } } } while (0)
#define GM_MMA(ai, bj, At, Bt) do { __builtin_amdgcn_s_setprio(1); _Pragma("unroll") for (int m = 0; m < 4; ++m) _Pragma("unroll") for (int n = 0; n < 2; ++n) { \
        if constexpr (F8) asm volatile("v_mfma_scale_f32_16x16x128_f8f6f4 %0, %1, %2, %0, %3, %4 op_sel_hi:[0,0,0]" : "+v"(acc[ai][bj][m][n]) : "v"(Bt##8[n]), "v"(At##8[m]), "v"(scW), "v"(scX)); \
        else { _Pragma("unroll") for (int k = 0; k < 2; ++k) acc[ai][bj][m][n] = __builtin_amdgcn_mfma_f32_16x16x32_bf16(Bt[n][k], At[m][k], acc[ai][bj][m][n], 0, 0, 0); } } \
        __builtin_amdgcn_s_setprio(0); } while (0)
#define GM_WAIT_V(n) asm volatile("s_waitcnt vmcnt(" #n ")" ::: "memory")
#define GM_WAIT_L(n) asm volatile("s_waitcnt lgkmcnt(" #n ")" ::: "memory")
#define GM_BAR __builtin_amdgcn_s_barrier()
    Unit cur, nxt; int ui = 0;
    if (!S.next(0, cur)) return;
    f32x4 acc[2][2][4][2];
#pragma unroll
    for (int a = 0; a < 2; ++a)
#pragma unroll
        for (int b = 0; b < 2; ++b)
#pragma unroll
            for (int m = 0; m < 4; ++m)
#pragma unroll
                for (int n = 0; n < 2; ++n) acc[a][b][m][n] = (f32x4){0.f, 0.f, 0.f, 0.f};
    bf16x8 At[4][2], B0[2][2], B1[2][2]; i32x8 At8[4], B08[2], B18[2];
    int scW = 0x7A7A7A7A, scX = 0x7F7F7F7F; asm volatile("" : "+v"(scW), "+v"(scX));
    const char* Ab = S.abase();
    unsigned coff[2][2], noff[2][2];
#pragma unroll
    for (int h = 0; h < 2; ++h)
#pragma unroll
        for (int i = 0; i < 2; ++i) coff[h][i] = S.aoff(cur, h * HALF + RA[i]) + CA2[i];
    const char* cB = S.bptr(cur);
    GM_STAGE_B(GM_SB(0, 0), cB); GM_STAGE_B(GM_SB(0, 1), cB + hstep); GM_STAGE_A(GM_SA(0, 0), coff[0], 0u); GM_STAGE_A(GM_SA(0, 1), coff[1], 0u);
    if (wr == 1) GM_BAR;
    GM_WAIT_V(2); GM_BAR;
    GM_STAGE_B(GM_SB(1, 0), cB + kstep); GM_STAGE_A(GM_SA(1, 0), coff[0], kstep); GM_STAGE_B(GM_SB(1, 1), cB + hstep + kstep);
    GM_WAIT_V(6); GM_BAR;
    for (;;) {
        const bool has_next = S.next(ui + 1, nxt);
        const char* nB = has_next ? S.bptr(nxt) : cB;
#pragma unroll
        for (int h = 0; h < 2; ++h)
#pragma unroll
            for (int i = 0; i < 2; ++i) noff[h][i] = has_next ? (S.aoff(nxt, h * HALF + RA[i]) + CA2[i]) : coff[h][i];
        for (int t = 0; t < nt; t += 2) {
            const bool last = (t == nt - 2);
            const unsigned k1 = (unsigned)(t + 1) * kstep;
            const unsigned k2 = last ? 0u : (unsigned)(t + 2) * kstep, k3 = k2 + kstep;
            const char* b2 = last ? nB : cB + (size_t)(t + 2) * kstep; const char* b3 = b2 + kstep;
            unsigned s2[2][2];
#pragma unroll
            for (int h = 0; h < 2; ++h)
#pragma unroll
                for (int i = 0; i < 2; ++i) s2[h][i] = last ? noff[h][i] : coff[h][i];
            GM_LDB(B0, 0, 0); GM_LDB(B1, 0, 1); SBAR(); GM_LDA(At, 0, 0); GM_STAGE_A(GM_SA(1, 1), coff[1], k1);
            GM_WAIT_V(8); GM_WAIT_L(0); GM_BAR; GM_MMA(0, 0, At, B0); GM_MMA(0, 1, At, B1); GM_BAR; SBAR();
            GM_LDA(At, 0, 1); GM_STAGE_B(GM_SB(0, 0), b2); GM_STAGE_B(GM_SB(0, 1), b2 + hstep); GM_STAGE_A(GM_SA(0, 0), s2[0], k2);
            GM_WAIT_V(8); GM_WAIT_L(0); GM_BAR; GM_MMA(1, 0, At, B0); GM_MMA(1, 1, At, B1); GM_BAR; SBAR();
            GM_LDB(B0, 1, 0); GM_LDB(B1, 1, 1); SBAR(); GM_LDA(At, 1, 0); GM_STAGE_A(GM_SA(0, 1), s2[1], k2);
            GM_WAIT_V(8); GM_WAIT_L(0); GM_BAR; GM_MMA(0, 0, At, B0); GM_MMA(0, 1, At, B1); GM_BAR; SBAR();
            GM_LDA(At, 1, 1); GM_STAGE_B(GM_SB(1, 0), b3); GM_STAGE_B(GM_SB(1, 1), b3 + hstep); GM_STAGE_A(GM_SA(1, 0), s2[0], k3);
            GM_WAIT_V(8); GM_WAIT_L(0); GM_BAR; GM_MMA(1, 0, At, B0); GM_MMA(1, 1, At, B1); GM_BAR; SBAR();
        }
        if (wr == 0) GM_BAR;
        if constexpr (F8) asm volatile("s_nop 15\n\ts_nop 15" ::: "memory");
        E(acc, cur, wr, wc, fr, fq);
        if (!has_next) break;
#pragma unroll
        for (int a = 0; a < 2; ++a)
#pragma unroll
            for (int b = 0; b < 2; ++b)
#pragma unroll
                for (int m = 0; m < 4; ++m)
#pragma unroll
                    for (int n = 0; n < 2; ++n) acc[a][b][m][n] = (f32x4){0.f, 0.f, 0.f, 0.f};
        cur = nxt; cB = nB; ++ui;
#pragma unroll
        for (int h = 0; h < 2; ++h)
#pragma unroll
            for (int i = 0; i < 2; ++i) coff[h][i] = noff[h][i];
        if (wr == 1) GM_BAR;
    }
    GM_WAIT_V(0);
    GM_BAR;
#undef GM_SA
#undef GM_SB
#undef GM_STAGE_A
#undef GM_STAGE_B
#undef GM_LD8
#undef GM_LDA
#undef GM_LDB
#undef GM_MMA
#undef GM_WAIT_V
#undef GM_WAIT_L
#undef GM_BAR
}

constexpr float QSCALE = 0.125f * 1.4426950408889634f;
struct EpiQKVU {
    bf16_t* Q; bf16_t* Kb; bf16_t* V; bf16_t* U; const float* rope;
    __device__ __forceinline__ void operator()(const f32x4 (&acc)[2][2][4][2], const Unit& u, int wr, int wc, int fr, int fq) const {
        const int kind = u.pn >> 1;
        bf16_t* base = kind == 0 ? Q : (kind == 1 ? Kb : (kind == 2 ? V : U));
        const int row0 = u.pm * BM + wr * 64 + fr, col0 = (u.pn & 1) * 256 + wc * 32 + 8 * fq;
        const bool dorope = (kind < 2) && ((wc & 1) == 0);
#pragma unroll
        for (int ai = 0; ai < 2; ++ai)
#pragma unroll
            for (int m = 0; m < 4; ++m) {
                const int row = row0 + ai * HALF + m * 16;
                bf16_t* rowp = base + (size_t)row * 512 + col0;
                f32x4 c0 = {1.f, 1.f, 1.f, 1.f}, c1 = c0, s0 = {0.f, 0.f, 0.f, 0.f}, s1 = s0;
                if (dorope) { const float* rp = rope + (size_t)(row & (SEQ - 1)) * 16; c0 = *(const f32x4*)(rp); c1 = *(const f32x4*)(rp + 4); s0 = *(const f32x4*)(rp + 8); s1 = *(const f32x4*)(rp + 12);
                    if (fq == 0) { s0 = -s0; s1 = -s1; } if (fq >= 2) { c0 = (f32x4){1.f, 1.f, 1.f, 1.f}; c1 = c0; s0 = (f32x4){0.f, 0.f, 0.f, 0.f}; s1 = s0; } }
#pragma unroll
                for (int bj = 0; bj < 2; ++bj) {
                    f32x4 v0 = acc[ai][bj][m][0], v1 = acc[ai][bj][m][1];
                    if (dorope) {
                        f32x4 p0, p1;
#pragma unroll
                        for (int j = 0; j < 4; ++j) { p0[j] = __shfl_xor(v0[j], 16); p1[j] = __shfl_xor(v1[j], 16); }
                        v0 = v0 * c0 + p0 * s0; v1 = v1 * c1 + p1 * s1;
                    }
                    if (kind == 0) { v0 = v0 * QSCALE; v1 = v1 * QSCALE; }
                    u32x4 w; w.x = cvt_pk_bf16(v0[0], v0[1]); w.y = cvt_pk_bf16(v0[2], v0[3]); w.z = cvt_pk_bf16(v1[0], v1[1]); w.w = cvt_pk_bf16(v1[2], v1[3]);
                    *(u32x4*)(rowp + bj * HALF) = w;
                }
            }
    }
};
struct EpiMix {
    bf16_t* D; const float* g1; const float* X;
    __device__ __forceinline__ void operator()(const f32x4 (&acc)[2][2][4][2], const Unit& u, int wr, int wc, int fr, int fq) const {
        const int row0 = u.pm * BM + wr * 64 + fr, col0 = u.pn * BM + wc * 32 + 8 * fq, b = (u.pm * BM) >> 11;
        f32x4 gv[2][2];
#pragma unroll
        for (int bj = 0; bj < 2; ++bj)
#pragma unroll
            for (int n = 0; n < 2; ++n) gv[bj][n] = *(const f32x4*)(g1 + (size_t)b * 6144 + col0 + bj * HALF + 4 * n);
#pragma unroll
        for (int ai = 0; ai < 2; ++ai) {
            f32x4 xv[4][2][2];
#pragma unroll
            for (int m = 0; m < 4; ++m)
#pragma unroll
                for (int bj = 0; bj < 2; ++bj)
#pragma unroll
                    for (int n = 0; n < 2; ++n) xv[m][bj][n] = *(const f32x4*)(X + (size_t)(row0 + ai * HALF + m * 16) * DM + col0 + bj * HALF + 4 * n);
#pragma unroll
            for (int m = 0; m < 4; ++m) { bf16_t* rowp = D + (size_t)(row0 + ai * HALF + m * 16) * DM + col0;
#pragma unroll
                for (int bj = 0; bj < 2; ++bj) { const f32x4 v0 = xv[m][bj][0] + gv[bj][0] * acc[ai][bj][m][0], v1 = xv[m][bj][1] + gv[bj][1] * acc[ai][bj][m][1];
                    u32x4 w; w.x = cvt_pk_bf16(v0[0], v0[1]); w.y = cvt_pk_bf16(v0[2], v0[3]); w.z = cvt_pk_bf16(v1[0], v1[1]); w.w = cvt_pk_bf16(v1[2], v1[3]);
                    *(u32x4*)(rowp + bj * HALF) = w; } }
        }
    }
};
struct EpiGateUp {
    unsigned char* HID;
    __device__ __forceinline__ void operator()(const f32x4 (&acc)[2][2][4][2], const Unit& u, int wr, int wc, int fr, int fq) const {
        const int row0 = u.pm * BM + wr * 64 + fr, col0 = u.pn * HALF + wc * 32 + 8 * fq;
#pragma unroll
        for (int ai = 0; ai < 2; ++ai)
#pragma unroll
            for (int m = 0; m < 4; ++m) { float h[8];
#pragma unroll
                for (int n = 0; n < 2; ++n)
#pragma unroll
                    for (int j = 0; j < 4; ++j) { const float g = acc[ai][0][m][n][j], up = acc[ai][1][m][n][j];
                        h[n * 4 + j] = g * up * __builtin_amdgcn_rcpf(1.f + __builtin_amdgcn_exp2f(-1.4426950408889634f * g)); }
                u32x2 w; w.x = pk4_fp8(h[0], h[1], h[2], h[3]); w.y = pk4_fp8(h[4], h[5], h[6], h[7]);
                *(u32x2*)(HID + (size_t)(row0 + ai * HALF + m * 16) * DEXP + col0) = w; }
    }
};
struct EpiDown {
    unsigned char* YS; const LAS int* tokrow; const LAS float* wrow;
    __device__ __forceinline__ void operator()(const f32x4 (&acc)[2][2][4][2], const Unit& u, int wr, int wc, int fr, int fq) const {
        const int r0 = wr * 64 + fr, col0 = u.pn * BM + wc * 32 + 8 * fq;
#pragma unroll
        for (int ai = 0; ai < 2; ++ai)
#pragma unroll
            for (int m = 0; m < 4; ++m) { const int r = r0 + ai * HALF + m * 16; const int dest = tokrow[u.li * 256 + r]; const float w8 = wrow[u.li * 256 + r];
                if (dest >= 0) {
#pragma unroll
                    for (int bj = 0; bj < 2; ++bj) { const f32x4 v0 = acc[ai][bj][m][0] * (w8 * 16.f), v1 = acc[ai][bj][m][1] * (w8 * 16.f);
                        u32x2 w; w.x = pk4_fp8(v0[0], v0[1], v0[2], v0[3]); w.y = pk4_fp8(v1[0], v1[1], v1[2], v1[3]);
                        *(u32x2*)(YS + (size_t)dest * DM + col0 + bj * HALF) = w; } } }
    }
};
}

namespace att {
constexpr int QBLK = 32, KVBLK = 64, LDK = 512;
constexpr float THRL = 8.f;
constexpr int SHM_V = KVBLK * 128 * 2, SHM_K = KVBLK * 128 * 2;
constexpr int SLOT = SHM_V + SHM_K, NSLOT = 3;
constexpr int OFF_WS = NSLOT * SLOT, OFF_XCH = 0  , ATT_LDS = OFF_WS + NWAVES * 64 * 4;
static_assert(4 * 64 * 64 * 4 <= 2 * SLOT, "exchange block fits two ring slots");
static_assert(ATT_LDS <= RING_BYTES, "attention LDS");
#define KSWZ(row, colB) ((row) * 256 + ((colB) ^ (((row) & 7) << 4)))
__device__ __forceinline__ int crow(int r, int hi) { return (r & 3) + 8 * (r >> 2) + 4 * hi; }
template <bool FIRST>
__device__ __forceinline__ void partialSM(f32x16& p0, f32x16& p1, float& mhat, float& alpha) {
    float a = fmaxf(fmaxf(p0[0], p0[1]), p1[0]), b = fmaxf(fmaxf(p0[2], p0[3]), p1[1]); a = fmaxf(fmaxf(a, p1[2]), p1[3]);
#pragma unroll
    for (int r = 4; r < 16; r += 4) { a = fmaxf(fmaxf(a, p0[r]), p0[r + 1]); b = fmaxf(fmaxf(b, p0[r + 2]), p0[r + 3]); a = fmaxf(fmaxf(a, p1[r]), p1[r + 1]); b = fmaxf(fmaxf(b, p1[r + 2]), p1[r + 3]); }
    float pmax = fmaxf(a, b);
    { auto rr = __builtin_amdgcn_permlane32_swap(__float_as_uint(pmax), __float_as_uint(pmax), false, false); pmax = fmaxf(__uint_as_float(rr[0]), __uint_as_float(rr[1])); }
    alpha = 1.f;
    if (FIRST || !__builtin_expect(__all(pmax <= THRL), 1)) {
        const float dl = FIRST ? pmax : fmaxf(pmax, 0.f);
        mhat += dl;
#pragma unroll
        for (int r = 0; r < 16; ++r) { p0[r] -= dl; p1[r] -= dl; }
        if (!FIRST) alpha = __builtin_amdgcn_exp2f(-dl);
    }
#pragma unroll
    for (int r = 0; r < 16; ++r) p0[r] = __builtin_amdgcn_exp2f(p0[r]);
}
__device__ __forceinline__ void finishSM(f32x16& p0, f32x16& p1, float alpha, float& l_reg, bf16x8& pa0, bf16x8& pa1, bf16x8& pa2, bf16x8& pa3) {
#pragma unroll
    for (int r = 0; r < 16; ++r) p1[r] = __builtin_amdgcn_exp2f(p1[r]);
    float ps = 0;
#pragma unroll
    for (int r = 0; r < 16; ++r) ps += p0[r];
#pragma unroll
    for (int r = 0; r < 16; ++r) ps += p1[r];
    { auto rr = __builtin_amdgcn_permlane32_swap(__float_as_uint(ps), __float_as_uint(ps), false, false); ps = __uint_as_float(rr[0]) + __uint_as_float(rr[1]); }
    l_reg = l_reg * alpha + ps;
#define PK4(P, BASE, OUT) do { unsigned a0 = cvt_pk_bf16(P[BASE + 0], P[BASE + 1]), a1 = cvt_pk_bf16(P[BASE + 2], P[BASE + 3]);   \
    unsigned b0 = cvt_pk_bf16(P[BASE + 4], P[BASE + 5]), b1 = cvt_pk_bf16(P[BASE + 6], P[BASE + 7]);                              \
    auto r0 = __builtin_amdgcn_permlane32_swap(a0, b0, false, false); auto r1 = __builtin_amdgcn_permlane32_swap(a1, b1, false, false); \
    u32x4 w = {r0[0], r1[0], r0[1], r1[1]}; OUT = *reinterpret_cast<bf16x8*>(&w); } while (0)
    PK4(p0, 0, pa0); PK4(p0, 8, pa1); PK4(p1, 0, pa2); PK4(p1, 8, pa3);
#undef PK4
}
__device__ __forceinline__ void qkt(f32x16& p0, f32x16& p1, const char* Ks, const bf16x8* qr, const float mhat, int r32, int hi, int kc0) {
    f32x16 negm;
#pragma unroll
    for (int r = 0; r < 16; ++r) negm[r] = -mhat;
#pragma unroll
    for (int d0 = 0; d0 < 4; ++d0) { const int cb = (kc0 + d0 * 16 + hi * 8) * 2;
        const bf16x8 b0 = *reinterpret_cast<const bf16x8*>(Ks + KSWZ(r32, cb));
        const bf16x8 b1 = *reinterpret_cast<const bf16x8*>(Ks + KSWZ(32 + r32, cb));
        if (d0 == 0) { p0 = __builtin_amdgcn_mfma_f32_32x32x16_bf16(b0, qr[0], negm, 0, 0, 0); p1 = __builtin_amdgcn_mfma_f32_32x32x16_bf16(b1, qr[0], negm, 0, 0, 0); }
        else { p0 = __builtin_amdgcn_mfma_f32_32x32x16_bf16(b0, qr[d0], p0, 0, 0, 0); p1 = __builtin_amdgcn_mfma_f32_32x32x16_bf16(b1, qr[d0], p1, 0, 0, 0); } }
}
__device__ __forceinline__ int v_st(int k, int c) { const int kk = (k & ~0xC) | ((k & 4) << 1) | ((k & 8) >> 1); return ((kk >> 3) * 4 + (c >> 5)) * 512 + ((kk & 7) * 32 + (c & 31)) * 2; }
__device__ __forceinline__ int v_rd_base(int lane) { return ((lane & 3) << 3) | (((lane >> 2) & 3) << 6) | (((lane >> 4) & 1) << 5) | (((lane >> 5) & 1) << 8); }
constexpr int v_rd_off(int d0, int ks, int half) { return d0 * 512 + ks * 4096 + half * 2048; }
template <int OFF> __device__ __forceinline__ s16x4 tr_read(int vb) { s16x4 r; asm volatile("ds_read_b64_tr_b16 %0, %1 offset:%2" : "=&v"(r) : "v"(vb), "i"(OFF) : "memory"); return r; }
struct VFrag { s16x4 l0, h0, l1, h1, l2, h2, l3, h3; };
template <int D0> __device__ __forceinline__ void v_reads(VFrag& f, int vb) {
    f.l0 = tr_read<v_rd_off(D0, 0, 0)>(vb); f.h0 = tr_read<v_rd_off(D0, 0, 1)>(vb); f.l1 = tr_read<v_rd_off(D0, 1, 0)>(vb); f.h1 = tr_read<v_rd_off(D0, 1, 1)>(vb);
    f.l2 = tr_read<v_rd_off(D0, 2, 0)>(vb); f.h2 = tr_read<v_rd_off(D0, 2, 1)>(vb); f.l3 = tr_read<v_rd_off(D0, 3, 0)>(vb); f.h3 = tr_read<v_rd_off(D0, 3, 1)>(vb);
}
__device__ __forceinline__ void pv_mma(f32x16& od, const VFrag& f, bf16x8 pa0, bf16x8 pa1, bf16x8 pa2, bf16x8 pa3) {
#define PK(L, H) (bf16x8){L[0], L[1], L[2], L[3], H[0], H[1], H[2], H[3]}
    od = __builtin_amdgcn_mfma_f32_32x32x16_bf16(pa0, PK(f.l0, f.h0), od, 0, 0, 0);
    od = __builtin_amdgcn_mfma_f32_32x32x16_bf16(pa1, PK(f.l1, f.h1), od, 0, 0, 0);
    od = __builtin_amdgcn_mfma_f32_32x32x16_bf16(pa2, PK(f.l2, f.h2), od, 0, 0, 0);
    od = __builtin_amdgcn_mfma_f32_32x32x16_bf16(pa3, PK(f.l3, f.h3), od, 0, 0, 0);
#undef PK
}
__device__ __forceinline__ void pv_d0(f32x16* o, int vb, bf16x8 pa0, bf16x8 pa1, bf16x8 pa2, bf16x8 pa3) {
    VFrag fa, fb;
    v_reads<0>(fa, vb);
    asm volatile("s_waitcnt lgkmcnt(0)" ::: "memory"); SBAR();
    v_reads<1>(fb, vb); SBAR();
    pv_mma(o[0], fa, pa0, pa1, pa2, pa3); SBAR();
    asm volatile("s_waitcnt lgkmcnt(0)" ::: "memory"); SBAR();
    v_reads<2>(fa, vb); SBAR();
    pv_mma(o[1], fb, pa0, pa1, pa2, pa3); SBAR();
    asm volatile("s_waitcnt lgkmcnt(0)" ::: "memory"); SBAR();
    v_reads<3>(fb, vb); SBAR();
    pv_mma(o[2], fa, pa0, pa1, pa2, pa3); SBAR();
    asm volatile("s_waitcnt lgkmcnt(0)" ::: "memory"); SBAR();
    pv_mma(o[3], fb, pa0, pa1, pa2, pa3);
}
constexpr int OFF_LAND = OFF_WS + NWAVES * 64 * 4;
static_assert(OFF_LAND + NWAVES * 4096 <= RING_BYTES, "landing buffers fit the phase scratch");
struct Weave { const float* wg; const float* wu; const float* wd; unsigned char* dgu; unsigned char* dd; int next, end, pend; };
__device__ __forceinline__ void weave_decode(const Weave& W, int B, int wid, const float*& src, int& ldw, unsigned char*& dst, int& ldd, int& n0, int& isup, int& type) {
    const int mat = B >> 6, within = B & 63, e = mat & 31; type = mat >> 5;
    int kblk, nblk;
    if (type < 2) { src = (type ? W.wu : W.wg) + (size_t)e * DM * DEXP; ldw = DEXP; kblk = within >> 3; nblk = within & 7; dst = W.dgu + (size_t)e * DM * DM; ldd = DM; }
    else { src = W.wd + (size_t)e * DEXP * DM; ldw = DM; kblk = within >> 4; nblk = within & 15; dst = W.dd + (size_t)e * DM * DEXP; ldd = DEXP; }
    isup = type == 1; n0 = nblk * 64;
    src += (size_t)(kblk * 128 + wid * 16) * ldw + n0; dst += kblk * 128 + wid * 16;
}
__device__ __forceinline__ void weave_step(Weave& W, char* lds, LAS unsigned char* ldsl, int wid, int lane) {
    if (W.pend >= 0) {
        const float* src; int ldw, ldd, n0, isup, type; unsigned char* dst;
        weave_decode(W, W.pend, wid, src, ldw, dst, ldd, n0, isup, type);
        const float* land = (const float*)(lds + OFF_LAND + wid * 4096) + lane;
        float v[16];
#pragma unroll
        for (int i = 0; i < 16; ++i) v[i] = land[i * 64] * 32.f;
        u32x4 o; o.x = pk4_fp8(v[0], v[1], v[2], v[3]); o.y = pk4_fp8(v[4], v[5], v[6], v[7]); o.z = pk4_fp8(v[8], v[9], v[10], v[11]); o.w = pk4_fp8(v[12], v[13], v[14], v[15]);
        const int n = n0 + lane; const int drow = type < 2 ? (256 * (n >> 7) + 128 * isup + (n & 127)) : n;
        *(GAS u32x4*)(dst + (size_t)drow * ldd) = o;
        asm volatile("s_waitcnt lgkmcnt(0)" ::: "memory");
        W.pend = -1;
    }
    if (W.next < W.end) {
        const float* src; int ldw, ldd, n0, isup, type; unsigned char* dst;
        weave_decode(W, W.next, wid, src, ldw, dst, ldd, n0, isup, type);
        const float* sp = src + lane;
#pragma unroll
        for (int i = 0; i < 16; ++i) __builtin_amdgcn_global_load_lds((const unsigned*)(sp + (size_t)i * ldw), (LAS unsigned*)(ldsl + OFF_LAND + wid * 4096 + i * 256), 4, 0, 0);
        W.pend = W.next; ++W.next;
    }
}
__device__ __forceinline__ void attn_unit(const bf16_t* __restrict__ Qg, const bf16_t* __restrict__ Kg, const bf16_t* __restrict__ Vg, bf16_t* MIX,
                                          int b, int h, int qblk, float lam, const float* __restrict__ subg, char* lds, LAS unsigned char* ldsl, Weave& wv) {
    const int tid = threadIdx.x, wid = __builtin_amdgcn_readfirstlane(tid >> 6), lane = tid & 63, r32 = lane & 31, hi = lane >> 5;
    const int comp = wid >> 2, wq = wid & 3;
    float* wsf = (float*)(lds + OFF_WS) + wid * 64; float* li_l = wsf; float* al_l = wsf + 32;
    float* xch = (float*)(lds + OFF_XCH) + wq * 4096;
    const long tok0 = (long)b * SEQ;
    float mhat = 0.f, l_reg = 0; f32x16 o[4] = {}; bf16x8 qr[4];
    const bf16_t* Qw = Qg + (tok0 + qblk * 128 + wq * QBLK + r32) * 512 + h * 128 + comp * 64 + hi * 8;
#pragma unroll
    for (int d0 = 0; d0 < 4; ++d0) qr[d0] = *reinterpret_cast<const bf16x8*>(Qw + d0 * 16);
    const char* Kb = (const char*)(Kg + tok0 * 512 + h * 128); const char* Vb = (const char*)(Vg + tok0 * 512 + h * 128);
    unsigned koff[2], voff[2];
#pragma unroll
    for (int i = 0; i < 2; ++i) { const int p_ = (wid * 2 + i) * 1024 + 16 * lane;
        { const int row = p_ >> 8, colB = (p_ & 255) ^ ((row & 7) << 4); koff[i] = (unsigned)(row * 1024 + colB); }
        { const int sub = p_ >> 9, kk = (sub >> 2) * 8 + ((p_ & 511) >> 6), c = (sub & 3) * 32 + (((p_ & 511) >> 1) & 31);
          const int k = (kk & ~0xC) | ((kk & 4) << 1) | ((kk & 8) >> 1); voff[i] = (unsigned)(k * 1024 + c * 2); } }
    const int vb0 = (int)(uintptr_t)lds + v_rd_base(lane);
    const int kc0 = comp * 64;
#define DMA_TILE(t, so) do { const char* kb_ = Kb + (size_t)(t) * (KVBLK * 1024); const char* vb_ = Vb + (size_t)(t) * (KVBLK * 1024); \
    _Pragma("unroll") for (int i_ = 0; i_ < 2; ++i_) { \
        __builtin_amdgcn_global_load_lds((const unsigned*)(vb_ + voff[i_]), (LAS unsigned*)(ldsl + (so) + (wid * 2 + i_) * 1024), 16, 0, 0); \
        __builtin_amdgcn_global_load_lds((const unsigned*)(kb_ + koff[i_]), (LAS unsigned*)(ldsl + (so) + SHM_V + (wid * 2 + i_) * 1024), 16, 0, 0); } } while (0)
#define WAIT_BAR(N) asm volatile("s_waitcnt vmcnt(" #N ") lgkmcnt(0)\n\ts_barrier" ::: "memory")
#define RESC(a) do { if (__any((a) < 1.f)) { if (hi == 0) al_l[r32] = (a); asm volatile("s_waitcnt lgkmcnt(0)" ::: "memory"); \
    _Pragma("unroll") for (int d = 0; d < 4; ++d) _Pragma("unroll") for (int r = 0; r < 16; ++r) o[d][r] *= al_l[crow(r, hi)]; } } while (0)
    f32x16 pA0, pA1, pB0, pB1; float alA, alB; bf16x8 pa0, pa1, pa2, pa3; constexpr int NT = SEQ / KVBLK;
    DMA_TILE(0, 0); DMA_TILE(1, SLOT);
    WAIT_BAR(4);
    qkt(pA0, pA1, lds + SHM_V, qr, mhat, r32, hi, kc0); partialSM<true>(pA0, pA1, mhat, alA);
    DMA_TILE(2, 2 * SLOT);
    WAIT_BAR(4);
    int s_prev = 0, s_cur = SLOT, s_next = 2 * SLOT;
#define ROT() do { const int t_ = s_prev; s_prev = s_cur; s_cur = s_next; s_next = t_; } while (0)
    for (int j = 1; j + 1 < NT; j += 2) {
        SBAR(); qkt(pB0, pB1, lds + s_cur + SHM_V, qr, mhat, r32, hi, kc0);
        finishSM(pA0, pA1, alA, l_reg, pa0, pa1, pa2, pa3); SBAR();
        pv_d0(o, vb0 + s_prev, pa0, pa1, pa2, pa3); partialSM<false>(pB0, pB1, mhat, alB);
        WAIT_BAR(0);
        if (j + 2 < NT) DMA_TILE(j + 2, s_prev);
        RESC(alB); ROT();
        SBAR(); qkt(pA0, pA1, lds + s_cur + SHM_V, qr, mhat, r32, hi, kc0);
        finishSM(pB0, pB1, alB, l_reg, pa0, pa1, pa2, pa3); SBAR();
        pv_d0(o, vb0 + s_prev, pa0, pa1, pa2, pa3); partialSM<false>(pA0, pA1, mhat, alA);
        WAIT_BAR(0);
        if (j + 3 < NT) DMA_TILE(j + 3, s_prev);
        weave_step(wv, lds, ldsl, wid, lane);
        RESC(alA); ROT();
    }
    SBAR(); qkt(pB0, pB1, lds + s_cur + SHM_V, qr, mhat, r32, hi, kc0);
    finishSM(pA0, pA1, alA, l_reg, pa0, pa1, pa2, pa3); SBAR();
    pv_d0(o, vb0 + s_prev, pa0, pa1, pa2, pa3); partialSM<false>(pB0, pB1, mhat, alB);
    RESC(alB);
    finishSM(pB0, pB1, alB, l_reg, pa0, pa1, pa2, pa3); SBAR();
    pv_d0(o, vb0 + s_cur, pa0, pa1, pa2, pa3);
    asm volatile("s_waitcnt lgkmcnt(0)\n\ts_barrier" ::: "memory");
    if (hi == 0) li_l[r32] = l_reg; asm volatile("s_waitcnt lgkmcnt(0)" ::: "memory");
    float rli[16];
#pragma unroll
    for (int r = 0; r < 16; ++r) rli[r] = __builtin_amdgcn_rcpf(li_l[crow(r, hi)]);
    if (comp == 1) {
#pragma unroll
        for (int d0 = 0; d0 < 4; ++d0)
#pragma unroll
            for (int r = 0; r < 16; ++r) xch[(d0 * 16 + r) * 64 + lane] = o[d0][r] * rli[r];
    }
    __syncthreads();
    if (comp == 0) {
        float rn[16];
#pragma unroll
        for (int r = 0; r < 16; ++r) { float s = 0.f;
#pragma unroll
            for (int d0 = 0; d0 < 4; ++d0) { const float v = o[d0][r] * rli[r] - lam * xch[(d0 * 16 + r) * 64 + lane]; o[d0][r] = v; s += v * v; }
            s += __shfl_xor(s, 1); s += __shfl_xor(s, 2); s += __shfl_xor(s, 4); s += __shfl_xor(s, 8); s += __shfl_xor(s, 16);
            rn[r] = __builtin_amdgcn_rsqf(s * (1.f / 128.f) + RMS_EPS) * 0.8f; }
        float gs[4];
#pragma unroll
        for (int d0 = 0; d0 < 4; ++d0) gs[d0] = subg[d0 * 32 + r32];
        asm volatile("s_waitcnt lgkmcnt(0)" ::: "memory");
        bf16_t* stg = (bf16_t*)xch;
#pragma unroll
        for (int r = 0; r < 16; ++r) { const int orow = crow(r, hi);
#pragma unroll
            for (int d0 = 0; d0 < 4; ++d0) stg[orow * 128 + d0 * 32 + r32] = (bf16_t)f2bf(o[d0][r] * rn[r] * gs[d0]); }
        asm volatile("s_waitcnt lgkmcnt(0)" ::: "memory");
        bf16_t* Ow = MIX + (tok0 + qblk * 128 + wq * QBLK) * 1024 + h * 128;
#pragma unroll
        for (int i = 0; i < 8; ++i) { const int row = i * 4 + (lane >> 4), ch = lane & 15; const u32x4 v = *(const u32x4*)(stg + row * 128 + ch * 8); *(u32x4*)(Ow + (long)row * 1024 + ch * 8) = v; }
    }
    asm volatile("s_waitcnt lgkmcnt(0)" ::: "memory");
    __syncthreads();
#undef DMA_TILE
#undef WAIT_BAR
#undef ROT
#undef RESC
}
#undef KSWZ
}

struct Params {
    const float *x, *c, *w_ada, *b_ada, *norm1_g, *w_in, *lq1, *lk1, *lq2, *lk2, *subln_g, *w_pool, *pool_scale, *w_out, *norm2_g, *w_rg, *b_rg, *w_re, *b_re, *w_gate, *w_up, *w_down, *final_g;
    float* out; unsigned char* ws; long long ph;
};
struct Frame { LAS unsigned char* lds; int tid, lane, wave, vcu, G; };

__device__ __forceinline__ void transpose_item(const float* W, int ldw, int k0, int n0, bf16_t* WT, size_t drow0, int ldd, int dcol0, LAS float* scr, int lane) {
#pragma unroll 8
    for (int i = 0; i < 32; ++i) { const int kk = 2 * i + (lane >> 5); scr[kk * 33 + (lane & 31)] = W[(size_t)(k0 + kk) * ldw + n0 + (lane & 31)]; }
    LDS_WAIT(); asm volatile("" ::: "memory");
    const int c = lane & 7;
#pragma unroll
    for (int j = 0; j < 4; ++j) { const int n = (lane >> 3) + 8 * j; const LAS float* s = scr + (8 * c) * 33 + n;
        u32x4 o; o.x = cvt_pk_bf16(s[0 * 33], s[1 * 33]); o.y = cvt_pk_bf16(s[2 * 33], s[3 * 33]); o.z = cvt_pk_bf16(s[4 * 33], s[5 * 33]); o.w = cvt_pk_bf16(s[6 * 33], s[7 * 33]);
        *(GAS u32x4*)(WT + (drow0 + n) * (size_t)ldd + dcol0 + 8 * c) = o; }
    LDS_WAIT(); asm volatile("" ::: "memory");
}
__device__ __forceinline__ void transpose_item_f8(const float* W, int ldw, int k0, int n0, unsigned char* WT, size_t drow0, int ldd, int dcol0, LAS float* scr, int lane) {
#pragma unroll 8
    for (int i = 0; i < 32; ++i) { const int kk = 2 * i + (lane >> 5); scr[kk * 33 + (lane & 31)] = W[(size_t)(k0 + kk) * ldw + n0 + (lane & 31)] * 32.f; }
    LDS_WAIT(); asm volatile("" ::: "memory");
    const int c = lane & 3;
#pragma unroll
    for (int j = 0; j < 2; ++j) { const int n = (lane >> 2) + 16 * j; const LAS float* s = scr + (16 * c) * 33 + n;
        u32x4 o; o.x = pk4_fp8(s[0 * 33], s[1 * 33], s[2 * 33], s[3 * 33]); o.y = pk4_fp8(s[4 * 33], s[5 * 33], s[6 * 33], s[7 * 33]);
        o.z = pk4_fp8(s[8 * 33], s[9 * 33], s[10 * 33], s[11 * 33]); o.w = pk4_fp8(s[12 * 33], s[13 * 33], s[14 * 33], s[15 * 33]);
        *(GAS u32x4*)(WT + (drow0 + n) * (size_t)ldd + dcol0 + 16 * c) = o; }
    LDS_WAIT(); asm volatile("" ::: "memory");
}
__device__ __forceinline__ void p0_prologue(const Params& P, Frame& F) {
    LAS float* scr = (LAS float*)(F.lds + F.wave * 16384);
    const int gw = F.vcu * NWAVES + F.wave, NGW = F.G * NWAVES, lane = F.lane;
    unsigned char* ws = P.ws;
    constexpr int T_MOD = 768, T_WF = 512, T_ROPE = 256, T_WR = 768, I_WIN = 1024, I_WOUT = 256;
    constexpr int NITEMS = T_MOD + T_WF + T_ROPE + T_WR + I_WIN + I_WOUT;
    for (int it = gw; it < NITEMS; it += NGW) {
        int r = it;
        if (r < T_MOD) {
            const int nc = r >> 3, kq = r & 7, n0 = nc * 64;
            for (int idx = lane; idx < 2048; idx += 64) { const int b = idx & 15, kk = idx >> 4; const float v = P.c[b * DM + kq * 128 + kk]; scr[kk * 16 + b] = v / (1.f + __expf(-v)); }
            LDS_WAIT(); asm volatile("" ::: "memory");
            float acc[16];
#pragma unroll
            for (int b = 0; b < 16; ++b) acc[b] = 0.f;
            const float* wp = P.w_ada + (size_t)(kq * 128) * 6144 + n0 + lane;
#pragma unroll 8
            for (int kk = 0; kk < 128; ++kk) { const float w = wp[(size_t)kk * 6144];
#pragma unroll
                for (int b4 = 0; b4 < 4; ++b4) { const f32x4 s = *(const LAS f32x4*)(scr + kk * 16 + b4 * 4); acc[b4 * 4 + 0] += w * s[0]; acc[b4 * 4 + 1] += w * s[1]; acc[b4 * 4 + 2] += w * s[2]; acc[b4 * 4 + 3] += w * s[3]; } }
            float* mp = (float*)(ws + WS_MODP) + (size_t)(kq * 16) * 6144 + n0 + lane;
#pragma unroll
            for (int b = 0; b < 16; ++b) mp[(size_t)b * 6144] = acc[b];
            LDS_WAIT(); asm volatile("" ::: "memory");
            continue; }
        r -= T_MOD;
        if (r < T_WF) {
            const int g = r >> 7, cc = (r >> 4) & 7, nc = r & 15, c0 = cc * 16, n0 = nc * 64;
            for (int idx = lane; idx < 2048; idx += 64) { const int d = idx & 127, c = idx >> 7; scr[d * 16 + c] = P.w_pool[(size_t)(g * 128 + c0 + c) * 128 + d] * P.pool_scale[g * 128 + d]; }
            LDS_WAIT(); asm volatile("" ::: "memory");
            float acc[16];
#pragma unroll
            for (int c = 0; c < 16; ++c) acc[c] = 0.f;
            const float* wp = P.w_out + (size_t)(512 + g * 128) * DM + n0 + lane;
#pragma unroll 8
            for (int d = 0; d < 128; ++d) { const float w = wp[(size_t)d * DM];
#pragma unroll
                for (int c4 = 0; c4 < 4; ++c4) { const f32x4 s = *(const LAS f32x4*)(scr + d * 16 + c4 * 4); acc[c4 * 4 + 0] += w * s[0]; acc[c4 * 4 + 1] += w * s[1]; acc[c4 * 4 + 2] += w * s[2]; acc[c4 * 4 + 3] += w * s[3]; } }
            bf16_t* dst = (bf16_t*)(ws + WS_WMIX) + (size_t)(n0 + lane) * DM + 512 + g * 128 + c0;
            u32x4 o0, o1; o0.x = pk2(acc[0], acc[1]); o0.y = pk2(acc[2], acc[3]); o0.z = pk2(acc[4], acc[5]); o0.w = pk2(acc[6], acc[7]);
            o1.x = pk2(acc[8], acc[9]); o1.y = pk2(acc[10], acc[11]); o1.z = pk2(acc[12], acc[13]); o1.w = pk2(acc[14], acc[15]);
            *(GAS u32x4*)dst = o0; *(GAS u32x4*)(dst + 8) = o1;
            LDS_WAIT(); asm volatile("" ::: "memory");
            continue; }
        r -= T_WF;
        if (r < T_ROPE) {
            const int idx = r * 64 + lane, pos = idx >> 3, j = idx & 7;
            const float invf = (float)exp(-(double)j * 1.640295422175541);
            const float ang = (float)pos * invf;
            const double rev = (double)ang * 0.15915494309189535; const float fr = (float)(rev - floor(rev));
            float* rp = (float*)(ws + WS_ROPE) + (size_t)pos * 16;
            rp[j] = __builtin_amdgcn_cosf(fr); rp[8 + j] = __builtin_amdgcn_sinf(fr);
            continue; }
        r -= T_ROPE;
        if (r < T_WR) {
            const int n = r >> 4, k = (r & 15) * 64 + lane;
            const float v = n < 4 ? P.w_rg[k * 4 + n] : (n < 36 ? P.w_re[k * 32 + (n - 4)] : 0.f);
            const unsigned hb = f2bf(v); const float lo = v - bf2f((unsigned short)hb);
            ((bf16_t*)(ws + WS_WRHI))[n * DM + k] = (bf16_t)hb; ((bf16_t*)(ws + WS_WRLO))[n * DM + k] = (bf16_t)f2bf(lo);
            continue; }
        r -= T_WR;
        if (r < I_WIN) { const int kb = r >> 6, nb = r & 63; transpose_item(P.w_in, 2048, kb * 64, nb * 32, (bf16_t*)(ws + WS_WIN), (size_t)nb * 32, DM, kb * 64, scr, lane); continue; }
        r -= I_WIN;
        { const int kb = r >> 5, nb = r & 31; transpose_item(P.w_out, DM, kb * 64, nb * 32, (bf16_t*)(ws + WS_WMIX), (size_t)nb * 32, DM, kb * 64, scr, lane); }
    }
}
__device__ __forceinline__ void p1_norm1(const Params& P, Frame& F) {
    const int gw = F.vcu * NWAVES + F.wave, NGW = F.G * NWAVES, lane = F.lane;
    unsigned char* ws = P.ws;
    const float* modp = (const float*)(ws + WS_MODP);
    for (int t = gw; t < 1536; t += NGW) {
        const int idx = t * 64 + lane, b = idx / 6144, n = idx - b * 6144;
        float v = P.b_ada[n];
#pragma unroll
        for (int kq = 0; kq < 8; ++kq) v += modp[(size_t)(kq * 16 + b) * 6144 + n];
        ((float*)(ws + WS_MODF))[idx] = v;
        if ((n >> 10) == 4) ((float*)(ws + WS_GM2))[b * DM + (n & 1023)] = P.norm2_g[n & 1023] * (1.f + v);
    }
    bf16_t* H1 = (bf16_t*)(ws + WS_H1);
    for (int g16 = gw; g16 < NTOK / 16; g16 += NGW) {
        const int row0 = g16 * 16, b = row0 >> 11;
        f32x4 gm[4], sh[4];
#pragma unroll
        for (int j = 0; j < 4; ++j) { const int col = 4 * lane + 256 * j;
            f32x4 s0 = *(const f32x4*)(P.b_ada + col), s1 = *(const f32x4*)(P.b_ada + 1024 + col);
#pragma unroll
            for (int kq = 0; kq < 8; ++kq) { const float* mp = modp + (size_t)(kq * 16 + b) * 6144 + col; s0 += *(const f32x4*)mp; s1 += *(const f32x4*)(mp + 1024); }
            sh[j] = s0; gm[j] = *(const f32x4*)(P.norm1_g + col) * (1.f + s1); }
        for (int rr = 0; rr < 16; ++rr) {
            const int row = row0 + rr;
            const GAS f32x4* xr = (const GAS f32x4*)(P.x + (size_t)row * DM) + lane;
            f32x4 v[4]; float s = 0.f;
#pragma unroll
            for (int j = 0; j < 4; ++j) { v[j] = xr[64 * j]; s += (v[j].x * v[j].x + v[j].y * v[j].y) + (v[j].z * v[j].z + v[j].w * v[j].w); }
            const float rstd = __builtin_amdgcn_rsqf(wave_sum(s) * (1.f / DM) + RMS_EPS);
            GAS u32x2* o8 = (GAS u32x2*)(H1 + (size_t)row * DM) + lane;
#pragma unroll
            for (int j = 0; j < 4; ++j) { const f32x4 hh = v[j] * rstd * gm[j] + sh[j]; u32x2 w; w.x = cvt_pk_bf16(hh.x, hh.y); w.y = cvt_pk_bf16(hh.z, hh.w); o8[64 * j] = w; }
        }
    }
}
__device__ __forceinline__ void p3_pooldiff(const Params& P, Frame& F) {
    const int gw = F.vcu * NWAVES + F.wave, NGW = F.G * NWAVES, lane = F.lane;
    const bf16_t* U = (const bf16_t*)(P.ws + WS_U); bf16_t* MIX = (bf16_t*)(P.ws + WS_MIXIN);
    const int g = lane >> 4, left = 1 << g, right = (1 << g) - 1;
    for (int t = gw; t < NTOK / 16; t += NGW) {
        const int row0 = t * 16, b = row0 >> 11, p0 = row0 & (SEQ - 1);
        const bf16_t* ub = U + (size_t)b * SEQ * 512 + lane * 8;
        float sum[8];
#pragma unroll
        for (int j = 0; j < 8; ++j) sum[j] = 0.f;
        { bf16x8 wv_[16];
#pragma unroll
          for (int q = 0; q < 16; ++q) { const int dj = q - 8, pj = p0 + dj; const bool in = dj >= -left && dj <= right && pj >= 0 && pj < SEQ;
              wv_[q] = in ? *(const bf16x8*)(ub + (size_t)pj * 512) : (bf16x8){0, 0, 0, 0, 0, 0, 0, 0}; }
#pragma unroll
          for (int q = 0; q < 16; ++q)
#pragma unroll
              for (int j = 0; j < 8; ++j) sum[j] += bf2f((unsigned short)wv_[q][j]); }
#pragma unroll
        for (int hb_ = 0; hb_ < 2; ++hb_) {
            bf16x8 cv[8], av[8], sv[8];
#pragma unroll
            for (int q = 0; q < 8; ++q) { const int p = p0 + hb_ * 8 + q, pa = p + 1 + right, ps = p - left;
                cv[q] = *(const bf16x8*)(ub + (size_t)p * 512);
                av[q] = pa < SEQ ? *(const bf16x8*)(ub + (size_t)pa * 512) : (bf16x8){0, 0, 0, 0, 0, 0, 0, 0};
                sv[q] = ps >= 0 ? *(const bf16x8*)(ub + (size_t)ps * 512) : (bf16x8){0, 0, 0, 0, 0, 0, 0, 0}; }
#pragma unroll
            for (int q = 0; q < 8; ++q) { const int p = p0 + hb_ * 8 + q;
                const int lo = p - left < 0 ? 0 : p - left, hi = p + right + 1 > SEQ ? SEQ : p + right + 1;
                const float inv = 1.f / (float)(hi - lo);
                float d[8];
#pragma unroll
                for (int j = 0; j < 8; ++j) d[j] = sum[j] * inv - bf2f((unsigned short)cv[q][j]);
                u32x4 w; w.x = cvt_pk_bf16(d[0], d[1]); w.y = cvt_pk_bf16(d[2], d[3]); w.z = cvt_pk_bf16(d[4], d[5]); w.w = cvt_pk_bf16(d[6], d[7]);
                *(u32x4*)(MIX + (size_t)(b * SEQ + p) * DM + 512 + lane * 8) = w;
#pragma unroll
                for (int j = 0; j < 8; ++j) sum[j] += bf2f((unsigned short)av[q][j]) - bf2f((unsigned short)sv[q][j]); }
        }
    }
}
#define EXPAND_BF(A, C, Dq) do { (A).x = __builtin_bit_cast(float, (Dq).x << 16); (A).y = __builtin_bit_cast(float, (Dq).x & 0xffff0000u); (A).z = __builtin_bit_cast(float, (Dq).y << 16); (A).w = __builtin_bit_cast(float, (Dq).y & 0xffff0000u); \
    (C).x = __builtin_bit_cast(float, (Dq).z << 16); (C).y = __builtin_bit_cast(float, (Dq).z & 0xffff0000u); (C).z = __builtin_bit_cast(float, (Dq).w << 16); (C).w = __builtin_bit_cast(float, (Dq).w & 0xffff0000u); } while (0)
__device__ __forceinline__ void p5_norm2_route(const Params& P, Frame& F, const int reps) {
    const int lane = F.lane, rr = lane & 15, kq = lane >> 4, kw = F.wave;
    unsigned char* ws = P.ws;
    LAS float* L_GM = (LAS float*)(F.lds); LAS float* L_SH = (LAS float*)(F.lds + 4096);
    LAS float* ssqp = (LAS float*)(F.lds + 8192);
    LAS float* L_BI = (LAS float*)(F.lds + 8192 + 1024);
    LAS float* lgp = (LAS float*)(F.lds + 12288);
    LAS int* rres = (LAS int*)(F.lds + 36864);
    LAS int* hist = (LAS int*)(F.lds + TB_HIST); LAS int* hb = (LAS int*)(F.lds + TB_HB);
    const float* gm2 = (const float*)(ws + WS_GM2); const float* modf = (const float*)(ws + WS_MODF);
    const bf16_t* wrhi = (const bf16_t*)(ws + WS_WRHI); const bf16_t* wrlo = (const bf16_t*)(ws + WS_WRLO);
    unsigned char* H2 = ws + WS_H2;
    int* rinfo = (int*)(ws + WS_RINFO); float* rw = (float*)(ws + WS_RW);
    gu32* cnt = (gu32*)(ws + WS_CTL) + CW_CNT;
    const int colb = kw * 128 + kq * 8;
    bf16x8 bhi[4][3], blo[4][3];
#pragma unroll
    for (int ks = 0; ks < 4; ++ks)
#pragma unroll
        for (int nb = 0; nb < 3; ++nb) { bhi[ks][nb] = *(const bf16x8*)(wrhi + (size_t)(nb * 16 + rr) * DM + colb + ks * 32); blo[ks][nb] = *(const bf16x8*)(wrlo + (size_t)(nb * 16 + rr) * DM + colb + ks * 32); }
    for (int rp_ = 0; rp_ < reps; ++rp_) { const bool dry = rp_ + 1 < reps;
    for (int blk = F.vcu; blk < NTOK / 128; blk += F.G) {
        const int b = (blk * 128) >> 11;
        if (F.tid < 256) { *(LAS f32x4*)(L_GM + 4 * F.tid) = *(const f32x4*)(gm2 + (size_t)b * DM + 4 * F.tid); *(LAS f32x4*)(L_SH + 4 * F.tid) = *(const f32x4*)(modf + (size_t)b * 6144 + 3 * 1024 + 4 * F.tid); }
        if (F.tid < 32) hist[F.tid] = 0;
        if (F.tid >= 64 && F.tid < 100) L_BI[F.tid - 64] = (F.tid < 68) ? P.b_rg[F.tid - 64] : P.b_re[F.tid - 68];
        const bf16_t* xbase = (const bf16_t*)(ws + WS_X1) + (size_t)(blk * 128 + rr) * DM + colb;
        f32x4 xa[4], xc[4]; u32x4 xl[4];
#pragma unroll
        for (int ks = 0; ks < 4; ++ks) xl[ks] = *(const u32x4*)(xbase + ks * 32);
        __syncthreads();
        for (int it = 0; it < 8; ++it) {
            const int row0 = blk * 128 + it * 16;
            float ssq = 0.f;
#pragma unroll
            for (int ks = 0; ks < 4; ++ks) { EXPAND_BF(xa[ks], xc[ks], xl[ks]); const f32x4 a = xa[ks], c = xc[ks]; ssq += (a.x * a.x + a.y * a.y) + (a.z * a.z + a.w * a.w) + (c.x * c.x + c.y * c.y) + (c.z * c.z + c.w * c.w); }
            ssq += __shfl_xor(ssq, 16); ssq += __shfl_xor(ssq, 32);
            if (kq == 0) ssqp[kw * 16 + rr] = ssq;
            __syncthreads();
            float tot = 0.f;
#pragma unroll
            for (int w = 0; w < 8; ++w) tot += ssqp[w * 16 + rr];
            const float rstd = __builtin_amdgcn_rsqf(tot * (1.f / DM) + RMS_EPS);
            f32x4 acc[3] = {{0.f, 0.f, 0.f, 0.f}, {0.f, 0.f, 0.f, 0.f}, {0.f, 0.f, 0.f, 0.f}};
            unsigned char* hrow = H2 + (size_t)(row0 + rr) * DM + colb;
            const bf16_t* xnext = xbase + (size_t)(it + 1) * 16 * DM;
#pragma unroll
            for (int ks = 0; ks < 4; ++ks) {
                const f32x4 g0 = *(const LAS f32x4*)(L_GM + colb + ks * 32), g1 = *(const LAS f32x4*)(L_GM + colb + ks * 32 + 4);
                const f32x4 s0 = *(const LAS f32x4*)(L_SH + colb + ks * 32), s1 = *(const LAS f32x4*)(L_SH + colb + ks * 32 + 4);
                const f32x4 h0 = xa[ks] * rstd * g0 + s0, h1 = xc[ks] * rstd * g1 + s1;
                if (it < 7) xl[ks] = *(const u32x4*)(xnext + ks * 32);
                u32x4 whi; whi.x = cvt_pk_bf16(h0.x, h0.y); whi.y = cvt_pk_bf16(h0.z, h0.w); whi.z = cvt_pk_bf16(h1.x, h1.y); whi.w = cvt_pk_bf16(h1.z, h1.w);
                f32x4 l0, l1;
                l0.x = h0.x - __builtin_bit_cast(float, whi.x << 16); l0.y = h0.y - __builtin_bit_cast(float, whi.x & 0xffff0000u);
                l0.z = h0.z - __builtin_bit_cast(float, whi.y << 16); l0.w = h0.w - __builtin_bit_cast(float, whi.y & 0xffff0000u);
                l1.x = h1.x - __builtin_bit_cast(float, whi.z << 16); l1.y = h1.y - __builtin_bit_cast(float, whi.z & 0xffff0000u);
                l1.z = h1.z - __builtin_bit_cast(float, whi.w << 16); l1.w = h1.w - __builtin_bit_cast(float, whi.w & 0xffff0000u);
                u32x4 wlo; wlo.x = cvt_pk_bf16(l0.x, l0.y); wlo.y = cvt_pk_bf16(l0.z, l0.w); wlo.z = cvt_pk_bf16(l1.x, l1.y); wlo.w = cvt_pk_bf16(l1.z, l1.w);
                { u32x2 w8; w8.x = pk4_fp8(h0.x, h0.y, h0.z, h0.w); w8.y = pk4_fp8(h1.x, h1.y, h1.z, h1.w); *(u32x2*)(hrow + ks * 32) = w8; }
                const bf16x8 ahi = __builtin_bit_cast(bf16x8, whi), alo = __builtin_bit_cast(bf16x8, wlo);
#pragma unroll
                for (int nb = 0; nb < 3; ++nb) {
                    acc[nb] = __builtin_amdgcn_mfma_f32_16x16x32_bf16(ahi, bhi[ks][nb], acc[nb], 0, 0, 0);
                    acc[nb] = __builtin_amdgcn_mfma_f32_16x16x32_bf16(alo, bhi[ks][nb], acc[nb], 0, 0, 0);
                    acc[nb] = __builtin_amdgcn_mfma_f32_16x16x32_bf16(ahi, blo[ks][nb], acc[nb], 0, 0, 0);
                }
            }
            LAS float* lgw = lgp + kw * 768;
#pragma unroll
            for (int nb = 0; nb < 3; ++nb)
#pragma unroll
                for (int r = 0; r < 4; ++r) lgw[(kq * 4 + r) * 48 + nb * 16 + rr] = acc[nb][r];
            __syncthreads();
            if (kw == it && lane < 16) {
                const LAS float* L = lgp + lane * 48;
#define LG(j) (((L[(j)] + L[768 + (j)]) + (L[1536 + (j)] + L[2304 + (j)])) + ((L[3072 + (j)] + L[3840 + (j)]) + (L[4608 + (j)] + L[5376 + (j)])))
                float gl[4]; int gs = 0; float gmx;
#pragma unroll
                for (int j = 0; j < 4; ++j) gl[j] = LG(j) + L_BI[j];
                gmx = gl[0];
#pragma unroll
                for (int j = 1; j < 4; ++j) if (gl[j] > gmx) { gmx = gl[j]; gs = j; }
                float gden = 0.f;
#pragma unroll
                for (int j = 0; j < 4; ++j) gden += __expf(gl[j] - gmx);
                const float gpv = 1.f / gden;
                float el[8];
#pragma unroll
                for (int j = 0; j < 8; ++j) el[j] = LG(4 + gs * 8 + j) + L_BI[4 + gs * 8 + j];
#undef LG
                int i0 = 0; float m0 = el[0];
#pragma unroll
                for (int j = 1; j < 8; ++j) if (el[j] > m0) { m0 = el[j]; i0 = j; }
                int i1 = -1; float m1 = -3.0e38f;
#pragma unroll
                for (int j = 0; j < 8; ++j) if (j != i0 && el[j] > m1) { m1 = el[j]; i1 = j; }
                const float tt = __expf(m1 - m0), den = 1.f / (1.f + tt);
                const int e0 = gs * 8 + i0, e1 = gs * 8 + i1;
                int lr0 = 0, lr1 = 0;
                if (!dry) { lr0 = atomicAdd((int*)(hist + e0), 1); lr1 = atomicAdd((int*)(hist + e1), 1); }
                LAS int* rp = rres + (it * 16 + lane) * 6;
                rp[0] = e0; rp[1] = e1; rp[2] = __builtin_bit_cast(int, gpv * den); rp[3] = __builtin_bit_cast(int, gpv * tt * den); rp[4] = lr0; rp[5] = lr1;
            }
        }
        __syncthreads();
        if (F.tid < 32 && !dry) { const int hc = hist[F.tid]; hb[F.tid] = hc ? (int)__hip_atomic_fetch_add(cnt + 64 * F.tid, (unsigned)hc, __ATOMIC_RELAXED, __HIP_MEMORY_SCOPE_AGENT) : 0; }
        __syncthreads();
        if (F.tid < 128 && !dry) { const LAS int* rp = rres + F.tid * 6; const int tok = blk * 128 + F.tid;
            const int e0 = rp[0], e1 = rp[1];
            const int p0 = e0 * ECAP + hb[e0] + rp[4], p1 = e1 * ECAP + hb[e1] + rp[5];
            rinfo[p0] = tok * 2; rw[p0] = __builtin_bit_cast(float, rp[2]); rinfo[p1] = tok * 2 + 1; rw[p1] = __builtin_bit_cast(float, rp[3]); }
        __syncthreads();
    }
    }
}
__device__ __forceinline__ int p6_tables(const Params& P, Frame& F) {
    LAS int* rt_e = (LAS int*)(F.lds + TB_RTE); LAS int* rtb = (LAS int*)(F.lds + TB_RTB); LAS int* cs = (LAS int*)(F.lds + TB_CNT);
    gu32* cnt = (gu32*)(P.ws + WS_CTL) + CW_CNT;
    if (F.tid < 32) cs[F.tid] = (int)__hip_atomic_load(cnt + 64 * F.tid, __ATOMIC_RELAXED, __HIP_MEMORY_SCOPE_AGENT);
    __syncthreads();
    if (F.tid == 0) { int a = 0; for (int e = 0; e < NEXP; ++e) { rtb[e] = a; a += (cs[e] + 255) >> 8; } rtb[NEXP] = a; }
    __syncthreads();
    const int nrt = rtb[NEXP];
    if (F.tid < nrt && F.tid < 320) { int e = 0; for (int j = 1; j < NEXP; ++j) e += (rtb[j] <= F.tid) ? 1 : 0; rt_e[F.tid] = e; }
    __syncthreads();
    return nrt;
}
__device__ __forceinline__ void p6_rowlists(const Params& P, Frame& F, const gm::MoeOrder& S) {
    LAS int* tokrow = (LAS int*)(F.lds + TB_TOK); LAS float* wrow = (LAS float*)(F.lds + TB_W); LAS int* cs = (LAS int*)(F.lds + TB_CNT);
    const int* rinfo = (const int*)(P.ws + WS_RINFO); const float* rw = (const float*)(P.ws + WS_RW);
    if (F.tid < 256) {
        int ti[MAXU]; float tw[MAXU]; bool have[MAXU];
#pragma unroll
        for (int li = 0; li < MAXU; ++li) { gm::Unit u; have[li] = S.next(li, u); ti[li] = -1; tw[li] = 0.f;
            if (have[li]) { const int idx = u.mt * 256 + F.tid; if (idx < cs[u.e]) { ti[li] = rinfo[(size_t)u.e * ECAP + idx]; tw[li] = rw[(size_t)u.e * ECAP + idx]; } } }
#pragma unroll
        for (int li = 0; li < MAXU; ++li) if (have[li]) { tokrow[li * 256 + F.tid] = ti[li]; wrow[li * 256 + F.tid] = tw[li]; }
    }
    __syncthreads();
}
__device__ __forceinline__ void p8_final(const Params& P, Frame& F, float* dst) {
    const int gw = F.vcu * NWAVES + F.wave, NGW = F.G * NWAVES, lane = F.lane;
    const unsigned char* YS = P.ws + WS_YS; const float* modf = (const float*)(P.ws + WS_MODF);
    f32x4 fg[4];
#pragma unroll
    for (int j = 0; j < 4; ++j) fg[j] = *(const f32x4*)(P.final_g + 4 * lane + 256 * j);
    for (int g16 = gw; g16 < NTOK / 16; g16 += NGW) {
        const int row0 = g16 * 16, b = row0 >> 11;
        f32x4 g2[4];
#pragma unroll
        for (int j = 0; j < 4; ++j) g2[j] = *(const f32x4*)(modf + (size_t)b * 6144 + 5 * 1024 + 4 * lane + 256 * j);
        for (int rr = 0; rr < 16; ++rr) {
            const int row = row0 + rr;
            const GAS u32x2* xr = (const GAS u32x2*)((const bf16_t*)(P.ws + WS_X1) + (size_t)row * DM) + lane;
            const GAS unsigned* ya = (const GAS unsigned*)(YS + (size_t)(2 * row) * DM) + lane; const GAS unsigned* yb = (const GAS unsigned*)(YS + (size_t)(2 * row + 1) * DM) + lane;
            f32x4 v[4]; float s = 0.f;
#pragma unroll
            for (int j = 0; j < 4; ++j) { const u32x2 dq = xr[64 * j]; const unsigned a = ya[64 * j], c = yb[64 * j];
                f32x4 xv; xv.x = __builtin_bit_cast(float, dq.x << 16); xv.y = __builtin_bit_cast(float, dq.x & 0xffff0000u); xv.z = __builtin_bit_cast(float, dq.y << 16); xv.w = __builtin_bit_cast(float, dq.y & 0xffff0000u);
                const f32x2 a0 = __builtin_amdgcn_cvt_pk_f32_fp8((int)a, false), a1 = __builtin_amdgcn_cvt_pk_f32_fp8((int)a, true), c0 = __builtin_amdgcn_cvt_pk_f32_fp8((int)c, false), c1 = __builtin_amdgcn_cvt_pk_f32_fp8((int)c, true);
                f32x4 y; y.x = a0.x + c0.x; y.y = a0.y + c0.y; y.z = a1.x + c1.x; y.w = a1.y + c1.y;
                v[j] = xv + g2[j] * (y * 0.0625f); s += (v[j].x * v[j].x + v[j].y * v[j].y) + (v[j].z * v[j].z + v[j].w * v[j].w); }
            const float rstd = __builtin_amdgcn_rsqf(wave_sum(s) * (1.f / DM) + RMS_EPS);
#pragma unroll
            for (int j = 0; j < 4; ++j) ((GAS f32x4*)(dst + (size_t)row * DM) + lane)[64 * j] = v[j] * rstd * fg[j];
        }
    }
}

__device__ __forceinline__ void ph2_inproj(const Params& P, Frame& F) {
    unsigned char* ws = P.ws;
    gm::DenseOrder S; S.init(ws + WS_H1, ws + WS_WIN, NTOK, 2048, DM, F.G, (int)blockIdx.x);
    gm::EpiQKVU E{(bf16_t*)(ws + WS_Q), (bf16_t*)(ws + WS_K), (bf16_t*)(ws + WS_V), (bf16_t*)(ws + WS_U), (const float*)(ws + WS_ROPE)};
    gm::gemm_phase<gm::EpiQKVU, gm::DenseOrder>(F.lds, S, E);
}
__device__ __forceinline__ void ph3_mixers(const Params& P, Frame& F, char* lds_gen, const int reps) {
    unsigned char* ws = P.ws;
    p3_pooldiff(P, F);
    const float lam = __expf(wave_sum(P.lq1[F.lane] * P.lk1[F.lane])) - __expf(wave_sum(P.lq2[F.lane] * P.lk2[F.lane])) + 0.2f;
    att::Weave wv{P.w_gate, P.w_up, P.w_down, ws + WS_WGU, ws + WS_WD, 0, 0, -1};
    { const int per = (6144 + F.G - 1) / F.G; wv.next = F.vcu * per; wv.end = wv.next + per < 6144 ? wv.next + per : 6144; if (wv.next > 6144) wv.next = 6144; }
    const int rounds = (NB * 4 * 16 + F.G - 1) / F.G;
    for (int ii = 0; ii < reps * rounds; ++ii) {
        const int i = ii % rounds;
        const int U = i * F.G + F.vcu; if (U >= NB * 4 * 16) continue;
        const int bh = U >> 4, qb = U & 15;
        att::attn_unit((const bf16_t*)(ws + WS_Q), (const bf16_t*)(ws + WS_K), (const bf16_t*)(ws + WS_V), (bf16_t*)(ws + WS_MIXIN), bh >> 2, bh & 3, qb, lam, P.subln_g, lds_gen, F.lds, wv);
    }
    while (wv.pend >= 0 || wv.next < wv.end) { asm volatile("s_waitcnt vmcnt(0)" ::: "memory"); att::weave_step(wv, lds_gen, F.lds, F.wave, F.lane); }
}
__device__ __forceinline__ void ph4_outproj(const Params& P, Frame& F) {
    unsigned char* ws = P.ws;
    gm::DenseOrder S; S.init(ws + WS_MIXIN, ws + WS_WMIX, NTOK, DM, DM, F.G, (int)blockIdx.x);
    gm::EpiMix E{(bf16_t*)(ws + WS_X1), (const float*)(ws + WS_MODF) + 2 * 1024, P.x};
    gm::gemm_phase<gm::EpiMix, gm::DenseOrder>(F.lds, S, E);
}
__device__ __forceinline__ void ph6_gateup(const Params& P, Frame& F, gm::MoeOrder S) {
    unsigned char* ws = P.ws;
    S.KB = DM; S.A = (const char*)(ws + WS_H2); S.Bt = (const char*)(ws + WS_WGU); S.bexp = (size_t)DM * DM; S.gather = true;
    gm::EpiGateUp E{ws + WS_HID};
    gm::gemm_phase<gm::EpiGateUp, gm::MoeOrder, true>(F.lds, S, E);
}
__device__ __forceinline__ void ph7_down(const Params& P, Frame& F, gm::MoeOrder S) {
    unsigned char* ws = P.ws;
    S.KB = DEXP; S.A = (const char*)(ws + WS_HID); S.Bt = (const char*)(ws + WS_WD); S.bexp = (size_t)DM * DEXP; S.gather = false;
    gm::EpiDown E{ws + WS_YS, (const LAS int*)(F.lds + TB_TOK), (const LAS float*)(F.lds + TB_W)};
    gm::gemm_phase<gm::EpiDown, gm::MoeOrder, true>(F.lds, S, E);
}

__global__ void __launch_bounds__(NTHR, 2) fwd_kernel(Params P) {
    extern __shared__ __attribute__((aligned(16))) unsigned char lds_raw[];
    Frame F;
    F.lds = (LAS unsigned char*)lds_raw;
    F.tid = threadIdx.x; F.lane = F.tid & 63; F.wave = __builtin_amdgcn_readfirstlane(F.tid >> 6);
    F.G = gridDim.x; { const int bx = blockIdx.x; F.vcu = (F.G % 8 == 0) ? (bx % 8) * (F.G / 8) + bx / 8 : bx; }
    unsigned char* ws = P.ws;
    gu32* ctl = (gu32*)(ws + WS_CTL);
    volatile LAS unsigned* MISC = (volatile LAS unsigned*)(F.lds + MISC_OFF);
    for (int u = F.tid; u < (LDS_BYTES - RING_BYTES) / 4; u += NTHR) ((LAS unsigned*)(F.lds + RING_BYTES))[u] = 0u;
    __syncthreads();
    const int lo = (int)(P.ph & 0xff), hi = (int)((P.ph >> 8) & 0xff), li = (int)((P.ph >> 16) & 0xff);
    XcdBarrier bar; bar.bar = (unsigned*)(ctl + CW_BAR) + li * XCD_BAR_WORDS; bar.x = 0; bar.st = nullptr;
    if (N_LAUNCHES != N_PHASES) bar = xcd_barrier_post((unsigned*)(ctl + CW_BAR) + li * XCD_BAR_WORDS, MISC + 8);
#define IN(k) (lo <= (k) && (k) < hi)
#define GRID_BAR(k) do { if (IN(k) && IN((k) + 1)) xcd_barrier(bar); } while (0)
#define RUN(k, call) do { if (IN(k)) { { constexpr int rep = 0; (void)rep; call; } if (PROBE_PHASE == (k)) { xcd_barrier(bar); { constexpr int rep = 1; (void)rep; call; } } GRID_BAR(k); } } while (0)

    RUN(0, p0_prologue(P, F));
    RUN(1, p1_norm1(P, F));
    RUN(2, ph2_inproj(P, F));
    if (IN(3)) { ph3_mixers(P, F, (char*)lds_raw, PROBE_PHASE == 3 ? 2 : 1); GRID_BAR(3); }
    RUN(4, ph4_outproj(P, F));
    if (IN(5)) { p5_norm2_route(P, F, PROBE_PHASE == 5 ? 2 : 1); GRID_BAR(5); }
    if (IN(6) || IN(7)) {
        const int nrt = p6_tables(P, F);
        gm::MoeOrder S; S.rt_e = (const LAS int*)(F.lds + TB_RTE); S.rtbase = (const LAS int*)(F.lds + TB_RTB); S.tokrow = (const LAS int*)(F.lds + TB_TOK);
        S.nunits = 4 * nrt; S.G = F.G; S.c = (int)blockIdx.x; S.KB = 0; S.A = nullptr; S.Bt = nullptr; S.bexp = 0; S.gather = false;
        p6_rowlists(P, F, S);
        RUN(6, ph6_gateup(P, F, S));
        RUN(7, ph7_down(P, F, S));
    }
    RUN(8, p8_final(P, F, (rep == 0 && PROBE_PHASE == 8) ? (float*)(ws + WS_A) : P.out));
#undef IN
#undef GRID_BAR
#undef RUN
}

extern "C" void kernel_launch(void* const* d_in, const int* in_sizes, int n_in, void* d_out, int out_size, void* d_ws, size_t ws_size, hipStream_t stream) {
    static int grid = 0;
    if (grid == 0) {
        if (n_in != 23 || in_sizes[0] != NTOK * DM || out_size != NTOK * DM || ws_size < WS_END) { fprintf(stderr, "kernel_launch: unexpected shapes (n_in %d, in0 %d, out %d, ws %zu)\n", n_in, n_in > 0 ? in_sizes[0] : -1, out_size, ws_size); grid = -1; return; }
        int dev = 0, cus = 0, per_cu = 0;
        if (hipGetDevice(&dev) != hipSuccess || hipDeviceGetAttribute(&cus, hipDeviceAttributeMultiprocessorCount, dev) != hipSuccess) { grid = -1; return; }
        if (hipFuncSetAttribute((const void*)fwd_kernel, hipFuncAttributeMaxDynamicSharedMemorySize, LDS_BYTES) != hipSuccess) { fprintf(stderr, "kernel_launch: hipFuncSetAttribute failed\n"); grid = -1; return; }
        if (hipOccupancyMaxActiveBlocksPerMultiprocessor(&per_cu, (const void*)fwd_kernel, NTHR, LDS_BYTES) != hipSuccess || per_cu < 1) fprintf(stderr, "kernel_launch: occupancy query reports %d\n", per_cu);
        (void)hipGetLastError();
        grid = cus;
    }
    if (grid < 0) return;
    if (hipMemsetAsync((char*)d_ws + WS_CTL, 0, CTL_ZERO_BYTES, stream) != hipSuccess) return;
    Params p{};
    const float** pp = (const float**)&p;
    for (int i = 0; i < 23; ++i) pp[i] = (const float*)d_in[i];
    p.out = (float*)d_out; p.ws = (unsigned char*)d_ws;
    if (N_LAUNCHES == 1) { p.ph = 0 | ((long long)N_PHASES << 8); hipLaunchKernelGGL(fwd_kernel, dim3(grid), dim3(NTHR), LDS_BYTES, stream, p); }
    else for (int k = 0; k < N_PHASES; ++k) {
        p.ph = (long long)k | ((long long)(k + 1) << 8); hipLaunchKernelGGL(fwd_kernel, dim3(grid), dim3(NTHR), LDS_BYTES, stream, p); }
}
```

```cpp
#include <hip/hip_runtime.h>
#include <cstdio>
#include <cstdint>

#ifndef MK_N_LAUNCHES
#define MK_N_LAUNCHES 1
#endif
#ifndef PROBE_PHASE
#define PROBE_PHASE -1
#endif
#ifndef PROBE_REGION
#define PROBE_REGION -1
#endif
#ifndef PROBE_AMP
#define PROBE_AMP 4
#endif
#define SWR_BEGIN(id) const long long swr_t0_##id = (PROBE_REGION == (id)) ? (long long)wall_clock64() : 0LL
#define SWR_END(id) do { if (PROBE_REGION == (id)) { if (threadIdx.x == 0) { const long long t1_ = wall_clock64(); const long long T_ = t1_ - swr_t0_##id; while ((long long)wall_clock64() - t1_ < (long long)PROBE_AMP * T_) __builtin_amdgcn_s_sleep(16); } __syncthreads(); } } while (0)
constexpr int N_PHASES = 9;
constexpr int N_LAUNCHES = MK_N_LAUNCHES;

#define GAS __attribute__((address_space(1)))
#define LAS __attribute__((address_space(3)))
typedef unsigned short bf16_t;
typedef short bf16x8 __attribute__((ext_vector_type(8)));
typedef short s16x4 __attribute__((ext_vector_type(4)));
typedef float f32x2 __attribute__((ext_vector_type(2)));
typedef float f32x4 __attribute__((ext_vector_type(4)));
typedef float f32x16 __attribute__((ext_vector_type(16)));
typedef unsigned u32x2 __attribute__((ext_vector_type(2)));
typedef unsigned u32x4 __attribute__((ext_vector_type(4)));
typedef GAS unsigned gu32;
typedef int i32x8 __attribute__((ext_vector_type(8)));
typedef int i32x4 __attribute__((ext_vector_type(4)));

constexpr int DM = 1024, NB = 16, SEQ = 2048, NTOK = NB * SEQ;
constexpr int NEXP = 32, DEXP = 512, ECAP = NTOK;
constexpr int NWAVES = 8, NTHR = NWAVES * 64;
constexpr float RMS_EPS = 1e-6f;
constexpr int MAXU = 6;

constexpr size_t MiB = 1u << 20;
constexpr size_t WS_CTL = 0, CTL_ZERO_BYTES = 1 * MiB;
constexpr size_t WS_MODP = 1 * MiB;
constexpr size_t WS_MODF = 4 * MiB;
constexpr size_t WS_GM2  = WS_MODF + 384 * 1024;
constexpr size_t WS_ROPE = WS_GM2 + 64 * 1024;
constexpr size_t WS_WRHI = WS_ROPE + 128 * 1024;
constexpr size_t WS_WRLO = WS_WRHI + 96 * 1024;
constexpr size_t WS_RINFO = 5 * MiB;
constexpr size_t WS_RW    = 9 * MiB;
constexpr size_t WS_WIN  = 13 * MiB;
constexpr size_t WS_WMIX = 17 * MiB;
constexpr size_t WS_WGU  = 19 * MiB;
constexpr size_t WS_WD   = 83 * MiB;
constexpr size_t WS_A    = 115 * MiB;
constexpr size_t WS_H1   = WS_A;
constexpr size_t WS_HID  = WS_A;
constexpr size_t WS_MIXIN = WS_A + 72 * MiB;
constexpr size_t WS_H2   = WS_A + 72 * MiB;
constexpr size_t WS_Q    = 251 * MiB;
constexpr size_t WS_K    = WS_Q + 32 * MiB;
constexpr size_t WS_V    = WS_K + 32 * MiB;
constexpr size_t WS_U    = WS_V + 32 * MiB;
constexpr size_t WS_X1 = WS_V;
constexpr size_t WS_YS   = WS_Q;
constexpr size_t WS_END  = 379 * MiB;
constexpr int CW_BAR = 4096;
constexpr int CW_CNT = 16384;

constexpr int RING_BYTES = 139264;
constexpr int TB_TOK = RING_BYTES;
constexpr int TB_W   = TB_TOK + MAXU * 1024;
constexpr int TB_RTE = TB_W + MAXU * 1024;
constexpr int TB_RTB = TB_RTE + 1280;
constexpr int TB_CNT = TB_RTB + 160;
constexpr int TB_HIST = TB_CNT + 128;
constexpr int TB_HB  = TB_HIST + 128;
constexpr int MISC_OFF = TB_HB + 128;
constexpr int LDS_BYTES = MISC_OFF + 128;
static_assert(LDS_BYTES <= 163840 && (MISC_OFF % 16) == 0, "LDS map");

#define LDS_WAIT() asm volatile("s_waitcnt lgkmcnt(0)" ::: "memory")
#define VM_WAIT() asm volatile("s_waitcnt vmcnt(0)" ::: "memory")
#define SBAR() __builtin_amdgcn_sched_barrier(0)
__device__ __forceinline__ unsigned f2bf(float f) { unsigned u = __builtin_bit_cast(unsigned, f); return (u + 0x7fffu + ((u >> 16) & 1u)) >> 16; }
__device__ __forceinline__ unsigned pk2(float lo, float hi) { return f2bf(lo) | (f2bf(hi) << 16); }
__device__ __forceinline__ float bf2f(unsigned short b) { return __builtin_bit_cast(float, (unsigned)b << 16); }
__device__ __forceinline__ unsigned cvt_pk_bf16(float lo, float hi) { unsigned r; asm volatile("v_cvt_pk_bf16_f32 %0, %1, %2" : "=v"(r) : "v"(lo), "v"(hi)); return r; }
__device__ __forceinline__ unsigned pk4_fp8(float a, float b, float c, float d) { int w = 0; w = __builtin_amdgcn_cvt_pk_fp8_f32(a, b, w, false); w = __builtin_amdgcn_cvt_pk_fp8_f32(c, d, w, true); return (unsigned)w; }
__device__ __forceinline__ float wave_sum(float v) {
#pragma unroll
    for (int o = 1; o < 64; o <<= 1) v += __shfl_xor(v, o);
    return v;
}

#define XB_TMO      128
#define XB_XCNT(j)  (256  + 64 * (j))
#define XB_XSUB(j)  (1280 + 64 * (j))
#define XB_XGEN(j)  (2304 + 64 * (j))
#define XB_TOP      3328
#define XB_TOPGEN   3392
#define XCD_BAR_WORDS 3456
#define XB_SPIN_CAP (1u << 18)
__device__ __forceinline__ unsigned xb_ld(unsigned* p)              { return __hip_atomic_load(p, __ATOMIC_RELAXED, __HIP_MEMORY_SCOPE_AGENT); }
__device__ __forceinline__ unsigned xb_add(unsigned* p, unsigned v) { return __hip_atomic_fetch_add(p, v, __ATOMIC_RELAXED, __HIP_MEMORY_SCOPE_AGENT); }
__device__ __forceinline__ unsigned xb_xcc_id() { return (unsigned)__builtin_amdgcn_s_getreg((3 << 11) | 20) & 0xFu; }
#define XB_SPIN(cond, bar) do { unsigned _sp = 0; while (cond) { __builtin_amdgcn_s_sleep(1); \
    if ((++_sp & 255u) == 0u) { if (xb_ld(&(bar)[XB_TMO])) break; if (_sp > XB_SPIN_CAP) { atomicAdd(&(bar)[XB_TMO], 1u); break; } } } } while (0)
struct XcdBarrier { unsigned* bar; unsigned x; volatile LAS unsigned* st; };
__device__ __forceinline__ XcdBarrier xcd_barrier_post(unsigned* bar, volatile LAS unsigned* st) {
    XcdBarrier b; b.bar = bar; b.x = xb_xcc_id(); b.st = st;
    if (threadIdx.x == 0) (void)xb_add(&bar[XB_XCNT(b.x)], 1u);
    return b;
}
__device__ __forceinline__ void xcd_barrier_complete(unsigned* bar, unsigned x, unsigned& nloc, unsigned& nx) {
    const unsigned G = gridDim.x * gridDim.y * gridDim.z;
    unsigned sum, cnt, mine, sp = 0u;
    for (;;) {
        sum = 0u; cnt = 0u; mine = 0u;
#pragma unroll
        for (unsigned j = 0; j < 16; ++j) { const unsigned c = xb_ld(&bar[XB_XCNT(j)]); sum += c; cnt += (c > 0u) ? 1u : 0u; mine = (j == x) ? c : mine; }
        if (sum == G) break;
        __builtin_amdgcn_s_sleep(1);
        if ((++sp & 255u) == 0u) { if (xb_ld(&bar[XB_TMO])) break; if (sp > XB_SPIN_CAP) { atomicAdd(&bar[XB_TMO], 1u); break; } }
    }
    nloc = mine > 0u ? mine : 1u; nx = cnt > 0u ? cnt : 1u;
}
__device__ __forceinline__ void xcd_barrier(const XcdBarrier& b) {
    asm volatile("s_waitcnt vmcnt(0)" ::: "memory");
    __syncthreads();
    if (threadIdx.x == 0) {
        unsigned* bar = b.bar;
        __builtin_amdgcn_s_waitcnt(0);
        unsigned nloc = b.st[0], nx = b.st[1];
        if (nloc == 0u) { xcd_barrier_complete(bar, b.x, nloc, nx); b.st[0] = nloc; b.st[1] = nx; }
        const unsigned old = xb_add(&bar[XB_XSUB(b.x)], 1u);
        const unsigned gen = old / nloc;
        if (old + 1u == (gen + 1u) * nloc) {
            __builtin_amdgcn_fence(__ATOMIC_RELEASE, "agent");
            asm volatile("s_waitcnt vmcnt(0)" ::: "memory");
            const unsigned og = xb_add(&bar[XB_TOP], 1u);
            const unsigned tg = og / nx;
            if (og + 1u == (tg + 1u) * nx) xb_add(&bar[XB_TOPGEN], 1u);
            else XB_SPIN(xb_ld(&bar[XB_TOPGEN]) == tg, bar);
            __builtin_amdgcn_fence(__ATOMIC_ACQUIRE, "agent");
            xb_add(&bar[XB_XGEN(b.x)], 1u);
            asm volatile("s_waitcnt vmcnt(0)" ::: "memory");
        } else {
            XB_SPIN(xb_ld(&bar[XB_XGEN(b.x)]) == gen, bar);
            __builtin_amdgcn_fence(__ATOMIC_ACQUIRE, "agent");
            asm volatile("s_waitcnt vmcnt(0)" ::: "memory");
        }
    }
    __syncthreads();
}

namespace gm {
constexpr int BM = 256, BK = 64, HALF = 128, HTB = HALF * BK * 2, STAGE_BYTES = 8 * HTB, NXCD = 8, WGM = 16;
__device__ __forceinline__ int lds_byte(int r, int c) { const int st = (r >> 4) * 2 + (c >> 5), rr = r & 15, cc = c & 31, ob = rr * 64 + cc * 2; return st * 1024 + (ob ^ (((ob >> 9) & 1) << 5)); }
__device__ __forceinline__ void stage_rc(int b, int& R, int& C) { const int st = b / 1024, sb = b % 1024, swz = sb ^ (((sb >> 9) & 1) << 5); R = (st >> 1) * 16 + swz / 64; C = (st & 1) * 32 + (swz % 64) / 2; }
__device__ __forceinline__ int perm32(int rho) { const int n = rho >> 4, i = rho & 15; return 8 * (i >> 2) + 4 * n + (i & 3); }
struct Unit { int pm, pn, e, mt, li; };

struct DenseOrder {
    int nM, nN, nwg, G, c, KB; const char* A; const char* Bt;
    __device__ __forceinline__ void init(const void* A_, const void* Bt_, int M, int N, int K_, int G_, int c_) { A = (const char*)A_; Bt = (const char*)Bt_; nM = M / BM; nN = N / BM; nwg = nM * nN; G = G_; c = c_; KB = K_ * 2; }
    __device__ __forceinline__ bool next(int i, Unit& u) const {
        const long L = (long)i * G + c; if (L >= nwg) return false;
        int wgid = (int)L; { const int q = nwg / NXCD, r = nwg % NXCD, xcd = wgid % NXCD, off = wgid / NXCD; wgid = (xcd < r ? xcd * (q + 1) : r * (q + 1) + (xcd - r) * q) + off; }
        const int nig = WGM * nN, gid = wgid / nig, fm = gid * WGM, gsz = (nM - fm) < WGM ? (nM - fm) : WGM;
        u.pm = fm + ((wgid % nig) % gsz); u.pn = (wgid % nig) / gsz; u.e = 0; u.mt = 0; u.li = i; return true;
    }
    __device__ __forceinline__ const char* abase() const { return A; }
    __device__ __forceinline__ unsigned aoff(const Unit& u, int r) const { return (unsigned)(u.pm * BM + r) * (unsigned)KB; }
    __device__ __forceinline__ const char* bptr(const Unit& u) const { return Bt + (size_t)u.pn * BM * KB; }
};
struct MoeOrder {
    const LAS int* rt_e; const LAS int* rtbase; const LAS int* tokrow; int nunits, G, c, KB; const char* A; const char* Bt; size_t bexp; bool gather;
    __device__ __forceinline__ bool next(int i, Unit& u) const {
        const long L = (long)i * G + c; if (L >= nunits) return false;
        int wgid = (int)L; { const int q = nunits / NXCD, r = nunits % NXCD, xcd = wgid % NXCD, off = wgid / NXCD; wgid = (xcd < r ? xcd * (q + 1) : r * (q + 1) + (xcd - r) * q) + off; }
        const int rt = wgid >> 2; const int e = __builtin_amdgcn_readfirstlane(rt_e[rt]); const int rb = __builtin_amdgcn_readfirstlane(rtbase[e]);
        u.pm = rt; u.pn = wgid & 3; u.e = e; u.mt = rt - rb; u.li = i; return true;
    }
    __device__ __forceinline__ const char* abase() const { return A; }
    __device__ __forceinline__ unsigned aoff(const Unit& u, int r) const {
        if (gather) { int t = tokrow[u.li * 256 + r] >> 1; t = t < 0 ? 0 : t; return (unsigned)t * (unsigned)KB; }
        return (unsigned)(u.pm * BM + r) * (unsigned)KB;
    }
    __device__ __forceinline__ const char* bptr(const Unit& u) const { return Bt + (size_t)u.e * bexp + (size_t)u.pn * BM * KB; }
};

template <class Epi, class Sched, bool F8 = false>
__device__ __forceinline__ void gemm_phase(LAS unsigned char* lds, const Sched& S, const Epi& E) {
    const int tid = threadIdx.x, wid = __builtin_amdgcn_readfirstlane(tid >> 6), lane = tid & 63, wr = wid >> 2, wc = wid & 3, fr = lane & 15, fq = lane >> 4;
    const int KB = S.KB, nt = KB / (BK * 2);
    int RA[2]; unsigned CA2[2], voffB[2];
#pragma unroll
    for (int i = 0; i < 2; ++i) { int R, C; stage_rc(tid * 16 + i * 8192, R, C); const int Rb = (R & ~31) + perm32(R & 31);
        RA[i] = R; CA2[i] = (unsigned)C * 2u; voffB[i] = (unsigned)(Rb * KB + C * 2); }
    const unsigned kstep = (unsigned)(BK * 2);
    const size_t hstep = (size_t)HALF * KB;
    const unsigned ldsw = (unsigned)wid * 1024u;
    const int aoff = lds_byte(wr * 64 + fr, fq * 8), boff = lds_byte(wc * 32 + fr, fq * 8);
#define GM_SA(b, h) (((b) * 2 + (h)) * HTB)
#define GM_SB(b, h) ((4 + (b) * 2 + (h)) * HTB)
#define GM_STAGE_B(bufoff, gbase) do { _Pragma("unroll") for (int _i = 0; _i < 2; ++_i) \
        __builtin_amdgcn_global_load_lds((const unsigned*)((const char*)(gbase) + voffB[_i]), (LAS unsigned*)(lds + (bufoff) + ldsw + _i * 8192), 16, 0, 0); } while (0)
#define GM_STAGE_A(bufoff, offs, koff) do { _Pragma("unroll") for (int _i = 0; _i < 2; ++_i) \
        __builtin_amdgcn_global_load_lds((const unsigned*)((Ab + (koff)) + (offs)[_i]), (LAS unsigned*)(lds + (bufoff) + ldsw + _i * 8192), 16, 0, 0); } while (0)
#define GM_LD8(p) __builtin_shufflevector(*(const LAS i32x4*)(p), *(const LAS i32x4*)((p) + 1024), 0, 1, 2, 3, 4, 5, 6, 7)
#define GM_LDA(dst, b, h) do { _Pragma("unroll") for (int m = 0; m < 4; ++m) { if constexpr (F8) dst##8[m] = GM_LD8(lds + GM_SA(b, h) + aoff + m * 2048); \
        else { _Pragma("unroll") for (int k = 0; k < 2; ++k) dst[m][k] = *(const LAS bf16x8*)(lds + GM_SA(b, h) + aoff + m * 2048 + k * 1024); } } } while (0)
#define GM_LDB(dst, b, h) do { _Pragma("unroll") for (int n = 0; n < 2; ++n) { if constexpr (F8) dst##8[n] = GM_LD8(lds + GM_SB(b, h) + boff + n * 2048); \
        else { _Pragma("unroll") for (int k = 0; k < 2; ++k) dst[n][k] = *(const LAS bf16x8*)(lds + GM_SB(b, h) + boff + n * 2048 + k * 1024); } } } while (0)
#define GM_MMA(ai, bj, At, Bt) do { __builtin_amdgcn_s_setprio(1); _Pragma("unroll") for (int m = 0; m < 4; ++m) _Pragma("unroll") for (int n = 0; n < 2; ++n) { \
        if constexpr (F8) asm volatile("v_mfma_scale_f32_16x16x128_f8f6f4 %0, %1, %2, %0, %3, %4 op_sel_hi:[0,0,0]" : "+v"(acc[ai][bj][m][n]) : "v"(Bt##8[n]), "v"(At##8[m]), "v"(scW), "v"(scX)); \
        else { _Pragma("unroll") for (int k = 0; k < 2; ++k) acc[ai][bj][m][n] = __builtin_amdgcn_mfma_f32_16x16x32_bf16(Bt[n][k], At[m][k], acc[ai][bj][m][n], 0, 0, 0); } } \
        __builtin_amdgcn_s_setprio(0); } while (0)
#define GM_WAIT_V(n) asm volatile("s_waitcnt vmcnt(" #n ")" ::: "memory")
#define GM_WAIT_L(n) asm volatile("s_waitcnt lgkmcnt(" #n ")" ::: "memory")
#define GM_BAR __builtin_amdgcn_s_barrier()
    Unit cur, nxt; int ui = 0;
    if (!S.next(0, cur)) return;
    f32x4 acc[2][2][4][2];
#pragma unroll
    for (int a = 0; a < 2; ++a)
#pragma unroll
        for (int b = 0; b < 2; ++b)
#pragma unroll
            for (int m = 0; m < 4; ++m)
#pragma unroll
                for (int n = 0; n < 2; ++n) acc[a][b][m][n] = (f32x4){0.f, 0.f, 0.f, 0.f};
    bf16x8 At[4][2], B0[2][2], B1[2][2]; i32x8 At8[4], B08[2], B18[2];
    int scW = 0x7A7A7A7A, scX = 0x7F7F7F7F; asm volatile("" : "+v"(scW), "+v"(scX));
    const char* Ab = S.abase();
    unsigned coff[2][2], noff[2][2];
#pragma unroll
    for (int h = 0; h < 2; ++h)
#pragma unroll
        for (int i = 0; i < 2; ++i) coff[h][i] = S.aoff(cur, h * HALF + RA[i]) + CA2[i];
    const char* cB = S.bptr(cur);
    GM_STAGE_B(GM_SB(0, 0), cB); GM_STAGE_B(GM_SB(0, 1), cB + hstep); GM_STAGE_A(GM_SA(0, 0), coff[0], 0u); GM_STAGE_A(GM_SA(0, 1), coff[1], 0u);
    if (wr == 1) GM_BAR;
    GM_WAIT_V(2); GM_BAR;
    GM_STAGE_B(GM_SB(1, 0), cB + kstep); GM_STAGE_A(GM_SA(1, 0), coff[0], kstep); GM_STAGE_B(GM_SB(1, 1), cB + hstep + kstep);
    GM_WAIT_V(6); GM_BAR;
    for (;;) {
        const bool has_next = S.next(ui + 1, nxt);
        const char* nB = has_next ? S.bptr(nxt) : cB;
#pragma unroll
        for (int h = 0; h < 2; ++h)
#pragma unroll
            for (int i = 0; i < 2; ++i) noff[h][i] = has_next ? (S.aoff(nxt, h * HALF + RA[i]) + CA2[i]) : coff[h][i];
        for (int t = 0; t < nt; t += 2) {
            const bool last = (t == nt - 2);
            const unsigned k1 = (unsigned)(t + 1) * kstep;
            const unsigned k2 = last ? 0u : (unsigned)(t + 2) * kstep, k3 = k2 + kstep;
            const char* b2 = last ? nB : cB + (size_t)(t + 2) * kstep; const char* b3 = b2 + kstep;
            unsigned s2[2][2];
#pragma unroll
            for (int h = 0; h < 2; ++h)
#pragma unroll
                for (int i = 0; i < 2; ++i) s2[h][i] = last ? noff[h][i] : coff[h][i];
            GM_LDB(B0, 0, 0); GM_LDB(B1, 0, 1); SBAR(); GM_LDA(At, 0, 0); GM_STAGE_A(GM_SA(1, 1), coff[1], k1);
            GM_WAIT_V(8); GM_WAIT_L(0); GM_BAR; GM_MMA(0, 0, At, B0); GM_MMA(0, 1, At, B1); GM_BAR; SBAR();
            GM_LDA(At, 0, 1); GM_STAGE_B(GM_SB(0, 0), b2); GM_STAGE_B(GM_SB(0, 1), b2 + hstep); GM_STAGE_A(GM_SA(0, 0), s2[0], k2);
            GM_WAIT_V(8); GM_WAIT_L(0); GM_BAR; GM_MMA(1, 0, At, B0); GM_MMA(1, 1, At, B1); GM_BAR; SBAR();
            GM_LDB(B0, 1, 0); GM_LDB(B1, 1, 1); SBAR(); GM_LDA(At, 1, 0); GM_STAGE_A(GM_SA(0, 1), s2[1], k2);
            GM_WAIT_V(8); GM_WAIT_L(0); GM_BAR; GM_MMA(0, 0, At, B0); GM_MMA(0, 1, At, B1); GM_BAR; SBAR();
            GM_LDA(At, 1, 1); GM_STAGE_B(GM_SB(1, 0), b3); GM_STAGE_B(GM_SB(1, 1), b3 + hstep); GM_STAGE_A(GM_SA(1, 0), s2[0], k3);
            GM_WAIT_V(8); GM_WAIT_L(0); GM_BAR; GM_MMA(1, 0, At, B0); GM_MMA(1, 1, At, B1); GM_BAR; SBAR();
        }
        if (wr == 0) GM_BAR;
        if constexpr (F8) asm volatile("s_nop 15\n\ts_nop 15" ::: "memory");
        E(acc, cur, wr, wc, fr, fq);
        if (!has_next) break;
#pragma unroll
        for (int a = 0; a < 2; ++a)
#pragma unroll
            for (int b = 0; b < 2; ++b)
#pragma unroll
                for (int m = 0; m < 4; ++m)
#pragma unroll
                    for (int n = 0; n < 2; ++n) acc[a][b][m][n] = (f32x4){0.f, 0.f, 0.f, 0.f};
        cur = nxt; cB = nB; ++ui;
#pragma unroll
        for (int h = 0; h < 2; ++h)
#pragma unroll
            for (int i = 0; i < 2; ++i) coff[h][i] = noff[h][i];
        if (wr == 1) GM_BAR;
    }
    GM_WAIT_V(0);
    GM_BAR;
#undef GM_SA
#undef GM_SB
#undef GM_STAGE_A
#undef GM_STAGE_B
#undef GM_LD8
#undef GM_LDA
#undef GM_LDB
#undef GM_MMA
#undef GM_WAIT_V
#undef GM_WAIT_L
#undef GM_BAR
}

constexpr float QSCALE = 0.125f * 1.4426950408889634f;
struct EpiQKVU {
    bf16_t* Q; bf16_t* Kb; bf16_t* V; bf16_t* U; const float* rope;
    __device__ __forceinline__ void operator()(const f32x4 (&acc)[2][2][4][2], const Unit& u, int wr, int wc, int fr, int fq) const {
        const int kind = u.pn >> 1;
        bf16_t* base = kind == 0 ? Q : (kind == 1 ? Kb : (kind == 2 ? V : U));
        const int row0 = u.pm * BM + wr * 64 + fr, col0 = (u.pn & 1) * 256 + wc * 32 + 8 * fq;
        const bool dorope = (kind < 2) && ((wc & 1) == 0);
#pragma unroll
        for (int ai = 0; ai < 2; ++ai)
#pragma unroll
            for (int m = 0; m < 4; ++m) {
                const int row = row0 + ai * HALF + m * 16;
                bf16_t* rowp = base + (size_t)row * 512 + col0;
                f32x4 c0 = {1.f, 1.f, 1.f, 1.f}, c1 = c0, s0 = {0.f, 0.f, 0.f, 0.f}, s1 = s0;
                if (dorope) { const float* rp = rope + (size_t)(row & (SEQ - 1)) * 16; c0 = *(const f32x4*)(rp); c1 = *(const f32x4*)(rp + 4); s0 = *(const f32x4*)(rp + 8); s1 = *(const f32x4*)(rp + 12);
                    if (fq == 0) { s0 = -s0; s1 = -s1; } if (fq >= 2) { c0 = (f32x4){1.f, 1.f, 1.f, 1.f}; c1 = c0; s0 = (f32x4){0.f, 0.f, 0.f, 0.f}; s1 = s0; } }
#pragma unroll
                for (int bj = 0; bj < 2; ++bj) {
                    f32x4 v0 = acc[ai][bj][m][0], v1 = acc[ai][bj][m][1];
                    if (dorope) {
                        f32x4 p0, p1;
#pragma unroll
                        for (int j = 0; j < 4; ++j) { p0[j] = __shfl_xor(v0[j], 16); p1[j] = __shfl_xor(v1[j], 16); }
                        v0 = v0 * c0 + p0 * s0; v1 = v1 * c1 + p1 * s1;
                    }
                    if (kind == 0) { v0 = v0 * QSCALE; v1 = v1 * QSCALE; }
                    u32x4 w; w.x = cvt_pk_bf16(v0[0], v0[1]); w.y = cvt_pk_bf16(v0[2], v0[3]); w.z = cvt_pk_bf16(v1[0], v1[1]); w.w = cvt_pk_bf16(v1[2], v1[3]);
                    *(u32x4*)(rowp + bj * HALF) = w;
                }
            }
    }
};
struct EpiMix {
    bf16_t* D; const float* g1; const float* X;
    __device__ __forceinline__ void operator()(const f32x4 (&acc)[2][2][4][2], const Unit& u, int wr, int wc, int fr, int fq) const {
        const int row0 = u.pm * BM + wr * 64 + fr, col0 = u.pn * BM + wc * 32 + 8 * fq, b = (u.pm * BM) >> 11;
        f32x4 gv[2][2];
#pragma unroll
        for (int bj = 0; bj < 2; ++bj)
#pragma unroll
            for (int n = 0; n < 2; ++n) gv[bj][n] = *(const f32x4*)(g1 + (size_t)b * 6144 + col0 + bj * HALF + 4 * n);
#pragma unroll
        for (int ai = 0; ai < 2; ++ai) {
            f32x4 xv[4][2][2];
#pragma unroll
            for (int m = 0; m < 4; ++m)
#pragma unroll
                for (int bj = 0; bj < 2; ++bj)
#pragma unroll
                    for (int n = 0; n < 2; ++n) xv[m][bj][n] = *(const f32x4*)(X + (size_t)(row0 + ai * HALF + m * 16) * DM + col0 + bj * HALF + 4 * n);
#pragma unroll
            for (int m = 0; m < 4; ++m) { bf16_t* rowp = D + (size_t)(row0 + ai * HALF + m * 16) * DM + col0;
#pragma unroll
                for (int bj = 0; bj < 2; ++bj) { const f32x4 v0 = xv[m][bj][0] + gv[bj][0] * acc[ai][bj][m][0], v1 = xv[m][bj][1] + gv[bj][1] * acc[ai][bj][m][1];
                    u32x4 w; w.x = cvt_pk_bf16(v0[0], v0[1]); w.y = cvt_pk_bf16(v0[2], v0[3]); w.z = cvt_pk_bf16(v1[0], v1[1]); w.w = cvt_pk_bf16(v1[2], v1[3]);
                    *(u32x4*)(rowp + bj * HALF) = w; } }
        }
    }
};
struct EpiGateUp {
    unsigned char* HID;
    __device__ __forceinline__ void operator()(const f32x4 (&acc)[2][2][4][2], const Unit& u, int wr, int wc, int fr, int fq) const {
        const int row0 = u.pm * BM + wr * 64 + fr, col0 = u.pn * HALF + wc * 32 + 8 * fq;
#pragma unroll
        for (int ai = 0; ai < 2; ++ai)
#pragma unroll
            for (int m = 0; m < 4; ++m) { float h[8];
#pragma unroll
                for (int n = 0; n < 2; ++n)
#pragma unroll
                    for (int j = 0; j < 4; ++j) { const float g = acc[ai][0][m][n][j], up = acc[ai][1][m][n][j];
                        h[n * 4 + j] = g * up * __builtin_amdgcn_rcpf(1.f + __builtin_amdgcn_exp2f(-1.4426950408889634f * g)); }
                u32x2 w; w.x = pk4_fp8(h[0], h[1], h[2], h[3]); w.y = pk4_fp8(h[4], h[5], h[6], h[7]);
                *(u32x2*)(HID + (size_t)(row0 + ai * HALF + m * 16) * DEXP + col0) = w; }
    }
};
struct EpiDown {
    unsigned char* YS; const LAS int* tokrow; const LAS float* wrow;
    __device__ __forceinline__ void operator()(const f32x4 (&acc)[2][2][4][2], const Unit& u, int wr, int wc, int fr, int fq) const {
        const int r0 = wr * 64 + fr, col0 = u.pn * BM + wc * 32 + 8 * fq;
#pragma unroll
        for (int ai = 0; ai < 2; ++ai)
#pragma unroll
            for (int m = 0; m < 4; ++m) { const int r = r0 + ai * HALF + m * 16; const int dest = tokrow[u.li * 256 + r]; const float w8 = wrow[u.li * 256 + r];
                if (dest >= 0) {
#pragma unroll
                    for (int bj = 0; bj < 2; ++bj) { const f32x4 v0 = acc[ai][bj][m][0] * (w8 * 16.f), v1 = acc[ai][bj][m][1] * (w8 * 16.f);
                        u32x2 w; w.x = pk4_fp8(v0[0], v0[1], v0[2], v0[3]); w.y = pk4_fp8(v1[0], v1[1], v1[2], v1[3]);
                        *(u32x2*)(YS + (size_t)dest * DM + col0 + bj * HALF) = w; } } }
    }
};
}

namespace att {
constexpr int QBLK = 32, KVBLK = 64, LDK = 512;
constexpr float THRL = 8.f;
constexpr int SHM_V = KVBLK * 128 * 2, SHM_K = KVBLK * 128 * 2;
constexpr int SLOT = SHM_V + SHM_K, NSLOT = 3;
constexpr int OFF_WS = NSLOT * SLOT, OFF_XCH = 0  , ATT_LDS = OFF_WS + NWAVES * 64 * 4;
static_assert(4 * 64 * 64 * 4 <= 2 * SLOT, "exchange block fits two ring slots");
static_assert(ATT_LDS <= RING_BYTES, "attention LDS");
#define KSWZ(row, colB) ((row) * 256 + ((colB) ^ (((row) & 7) << 4)))
__device__ __forceinline__ int crow(int r, int hi) { return (r & 3) + 8 * (r >> 2) + 4 * hi; }
template <bool FIRST>
__device__ __forceinline__ void partialSM(f32x16& p0, f32x16& p1, float& mhat, float& alpha) {
    float a = fmaxf(fmaxf(p0[0], p0[1]), p1[0]), b = fmaxf(fmaxf(p0[2], p0[3]), p1[1]); a = fmaxf(fmaxf(a, p1[2]), p1[3]);
#pragma unroll
    for (int r = 4; r < 16; r += 4) { a = fmaxf(fmaxf(a, p0[r]), p0[r + 1]); b = fmaxf(fmaxf(b, p0[r + 2]), p0[r + 3]); a = fmaxf(fmaxf(a, p1[r]), p1[r + 1]); b = fmaxf(fmaxf(b, p1[r + 2]), p1[r + 3]); }
    float pmax = fmaxf(a, b);
    { auto rr = __builtin_amdgcn_permlane32_swap(__float_as_uint(pmax), __float_as_uint(pmax), false, false); pmax = fmaxf(__uint_as_float(rr[0]), __uint_as_float(rr[1])); }
    alpha = 1.f;
    if (FIRST || !__builtin_expect(__all(pmax <= THRL), 1)) {
        const float dl = FIRST ? pmax : fmaxf(pmax, 0.f);
        mhat += dl;
#pragma unroll
        for (int r = 0; r < 16; ++r) { p0[r] -= dl; p1[r] -= dl; }
        if (!FIRST) alpha = __builtin_amdgcn_exp2f(-dl);
    }
#pragma unroll
    for (int r = 0; r < 16; ++r) p0[r] = __builtin_amdgcn_exp2f(p0[r]);
#pragma unroll
    for (int r = 0; r < 16; ++r) p1[r] = __builtin_amdgcn_exp2f(p1[r]);
}
__device__ __forceinline__ void finishSM(f32x16& p0, f32x16& p1, float alpha, float& l_reg, bf16x8& pa0, bf16x8& pa1, bf16x8& pa2, bf16x8& pa3) {
    float ps = 0;
#pragma unroll
    for (int r = 0; r < 16; ++r) ps += p0[r];
#pragma unroll
    for (int r = 0; r < 16; ++r) ps += p1[r];
    { auto rr = __builtin_amdgcn_permlane32_swap(__float_as_uint(ps), __float_as_uint(ps), false, false); ps = __uint_as_float(rr[0]) + __uint_as_float(rr[1]); }
    l_reg = l_reg * alpha + ps;
#define PK4(P, BASE, OUT) do { unsigned a0 = cvt_pk_bf16(P[BASE + 0], P[BASE + 1]), a1 = cvt_pk_bf16(P[BASE + 2], P[BASE + 3]);   \
    unsigned b0 = cvt_pk_bf16(P[BASE + 4], P[BASE + 5]), b1 = cvt_pk_bf16(P[BASE + 6], P[BASE + 7]);                              \
    auto r0 = __builtin_amdgcn_permlane32_swap(a0, b0, false, false); auto r1 = __builtin_amdgcn_permlane32_swap(a1, b1, false, false); \
    u32x4 w = {r0[0], r1[0], r0[1], r1[1]}; OUT = *reinterpret_cast<bf16x8*>(&w); } while (0)
    PK4(p0, 0, pa0); PK4(p0, 8, pa1); PK4(p1, 0, pa2); PK4(p1, 8, pa3);
#undef PK4
}
__device__ __forceinline__ void qkt(f32x16& p0, f32x16& p1, const char* Ks, const bf16x8* qr, const float mhat, int r32, int hi, int kc0) {
    f32x16 negm;
#pragma unroll
    for (int r = 0; r < 16; ++r) negm[r] = -mhat;
#pragma unroll
    for (int d0 = 0; d0 < 4; ++d0) { const int cb = (kc0 + d0 * 16 + hi * 8) * 2;
        const bf16x8 b0 = *reinterpret_cast<const bf16x8*>(Ks + KSWZ(r32, cb));
        const bf16x8 b1 = *reinterpret_cast<const bf16x8*>(Ks + KSWZ(32 + r32, cb));
        if (d0 == 0) { p0 = __builtin_amdgcn_mfma_f32_32x32x16_bf16(b0, qr[0], negm, 0, 0, 0); p1 = __builtin_amdgcn_mfma_f32_32x32x16_bf16(b1, qr[0], negm, 0, 0, 0); }
        else { p0 = __builtin_amdgcn_mfma_f32_32x32x16_bf16(b0, qr[d0], p0, 0, 0, 0); p1 = __builtin_amdgcn_mfma_f32_32x32x16_bf16(b1, qr[d0], p1, 0, 0, 0); } }
}
__device__ __forceinline__ int v_st(int k, int c) { const int kk = (k & ~0xC) | ((k & 4) << 1) | ((k & 8) >> 1); return ((kk >> 3) * 4 + (c >> 5)) * 512 + ((kk & 7) * 32 + (c & 31)) * 2; }
__device__ __forceinline__ int v_rd_base(int lane) { return ((lane & 3) << 3) | (((lane >> 2) & 3) << 6) | (((lane >> 4) & 1) << 5) | (((lane >> 5) & 1) << 8); }
constexpr int v_rd_off(int d0, int ks, int half) { return d0 * 512 + ks * 4096 + half * 2048; }
template <int OFF> __device__ __forceinline__ s16x4 tr_read(int vb) { s16x4 r; asm volatile("ds_read_b64_tr_b16 %0, %1 offset:%2" : "=&v"(r) : "v"(vb), "i"(OFF) : "memory"); return r; }
struct VFrag { s16x4 l0, h0, l1, h1, l2, h2, l3, h3; };
template <int D0> __device__ __forceinline__ void v_reads(VFrag& f, int vb) {
    f.l0 = tr_read<v_rd_off(D0, 0, 0)>(vb); f.h0 = tr_read<v_rd_off(D0, 0, 1)>(vb); f.l1 = tr_read<v_rd_off(D0, 1, 0)>(vb); f.h1 = tr_read<v_rd_off(D0, 1, 1)>(vb);
    f.l2 = tr_read<v_rd_off(D0, 2, 0)>(vb); f.h2 = tr_read<v_rd_off(D0, 2, 1)>(vb); f.l3 = tr_read<v_rd_off(D0, 3, 0)>(vb); f.h3 = tr_read<v_rd_off(D0, 3, 1)>(vb);
}
__device__ __forceinline__ void pv_mma(f32x16& od, const VFrag& f, bf16x8 pa0, bf16x8 pa1, bf16x8 pa2, bf16x8 pa3) {
#define PK(L, H) (bf16x8){L[0], L[1], L[2], L[3], H[0], H[1], H[2], H[3]}
    od = __builtin_amdgcn_mfma_f32_32x32x16_bf16(pa0, PK(f.l0, f.h0), od, 0, 0, 0);
    od = __builtin_amdgcn_mfma_f32_32x32x16_bf16(pa1, PK(f.l1, f.h1), od, 0, 0, 0);
    od = __builtin_amdgcn_mfma_f32_32x32x16_bf16(pa2, PK(f.l2, f.h2), od, 0, 0, 0);
    od = __builtin_amdgcn_mfma_f32_32x32x16_bf16(pa3, PK(f.l3, f.h3), od, 0, 0, 0);
#undef PK
}
#ifndef SM_E1
#define SM_E1 11
#endif
#ifndef SM_E2
#define SM_E2 22
#endif
__device__ __forceinline__ void pv_d0(f32x16* o, int vb, bf16x8 pa0, bf16x8 pa1, bf16x8 pa2, bf16x8 pa3) {
    VFrag fa, fb;
    v_reads<0>(fa, vb);
    asm volatile("s_waitcnt lgkmcnt(0)" ::: "memory"); SBAR();
    v_reads<1>(fb, vb); SBAR();
    pv_mma(o[0], fa, pa0, pa1, pa2, pa3); SBAR();
    asm volatile("s_waitcnt lgkmcnt(0)" ::: "memory"); SBAR();
    v_reads<2>(fa, vb); SBAR();
    pv_mma(o[1], fb, pa0, pa1, pa2, pa3); SBAR();
    asm volatile("s_waitcnt lgkmcnt(0)" ::: "memory"); SBAR();
    v_reads<3>(fb, vb); SBAR();
    pv_mma(o[2], fa, pa0, pa1, pa2, pa3); SBAR();
    asm volatile("s_waitcnt lgkmcnt(0)" ::: "memory"); SBAR();
    pv_mma(o[3], fb, pa0, pa1, pa2, pa3);
}
template <int LO, int HI> __device__ __forceinline__ void exp_range(f32x16& p0, f32x16& p1) {
#pragma unroll
    for (int r = LO; r < HI; ++r) { if (r < 16) p0[r] = __builtin_amdgcn_exp2f(p0[r]); else p1[r - 16] = __builtin_amdgcn_exp2f(p1[r - 16]); }
}
__device__ __forceinline__ void pv_sm(f32x16* o, int vb, bf16x8 pa0, bf16x8 pa1, bf16x8 pa2, bf16x8 pa3, f32x16& p0, f32x16& p1, float& mhat, float& alpha) {
    VFrag fa, fb;
    v_reads<0>(fa, vb);
    asm volatile("s_waitcnt lgkmcnt(0)" ::: "memory"); SBAR();
    v_reads<1>(fb, vb); SBAR();
    pv_mma(o[0], fa, pa0, pa1, pa2, pa3);
    float a = fmaxf(fmaxf(p0[0], p0[1]), p1[0]), b = fmaxf(fmaxf(p0[2], p0[3]), p1[1]); a = fmaxf(fmaxf(a, p1[2]), p1[3]);
#pragma unroll
    for (int r = 4; r < 16; r += 4) { a = fmaxf(fmaxf(a, p0[r]), p0[r + 1]); b = fmaxf(fmaxf(b, p0[r + 2]), p0[r + 3]); a = fmaxf(fmaxf(a, p1[r]), p1[r + 1]); b = fmaxf(fmaxf(b, p1[r + 2]), p1[r + 3]); }
    float pmax = fmaxf(a, b);
    { auto rr = __builtin_amdgcn_permlane32_swap(__float_as_uint(pmax), __float_as_uint(pmax), false, false); pmax = fmaxf(__uint_as_float(rr[0]), __uint_as_float(rr[1])); }
    asm volatile("" : "+v"(pmax));
    SBAR();
    asm volatile("s_waitcnt lgkmcnt(0)" ::: "memory"); SBAR();
    v_reads<2>(fa, vb); SBAR();
    alpha = 1.f;
    if (!__builtin_expect(__all(pmax <= THRL), 1)) {
        const float dl = fmaxf(pmax, 0.f);
        mhat += dl;
#pragma unroll
        for (int r = 0; r < 16; ++r) { p0[r] -= dl; p1[r] -= dl; }
        alpha = __builtin_amdgcn_exp2f(-dl);
    }
    SBAR();
    pv_mma(o[1], fb, pa0, pa1, pa2, pa3);
    exp_range<0, SM_E1>(p0, p1);
    asm volatile("" : "+v"(p0), "+v"(p1));
    SBAR();
    asm volatile("s_waitcnt lgkmcnt(0)" ::: "memory"); SBAR();
    v_reads<3>(fb, vb); SBAR();
    pv_mma(o[2], fa, pa0, pa1, pa2, pa3);
    exp_range<SM_E1, SM_E2>(p0, p1);
    asm volatile("" : "+v"(p0), "+v"(p1));
    SBAR();
    asm volatile("s_waitcnt lgkmcnt(0)" ::: "memory"); SBAR();
    pv_mma(o[3], fb, pa0, pa1, pa2, pa3);
    exp_range<SM_E2, 32>(p0, p1);
    asm volatile("" : "+v"(p0), "+v"(p1), "+v"(o[3]));
}
#ifndef WEAVE_AUX
#define WEAVE_AUX 2
#endif
constexpr int OFF_LAND = OFF_WS + NWAVES * 64 * 4;
static_assert(OFF_LAND + NWAVES * 4096 <= RING_BYTES, "landing buffers fit the phase scratch");
struct Weave { const float* wg; const float* wu; const float* wd; unsigned char* dgu; unsigned char* dd; int next, end, pend; };
__device__ __forceinline__ void weave_decode(const Weave& W, int B, int wid, const float*& src, int& ldw, unsigned char*& dst, int& ldd, int& n0, int& isup, int& type) {
    const int mat = B >> 6, within = B & 63, e = mat & 31; type = mat >> 5;
    int kblk, nblk;
    if (type < 2) { src = (type ? W.wu : W.wg) + (size_t)e * DM * DEXP; ldw = DEXP; kblk = within >> 3; nblk = within & 7; dst = W.dgu + (size_t)e * DM * DM; ldd = DM; }
    else { src = W.wd + (size_t)e * DEXP * DM; ldw = DM; kblk = within >> 4; nblk = within & 15; dst = W.dd + (size_t)e * DM * DEXP; ldd = DEXP; }
    isup = type == 1; n0 = nblk * 64;
    src += (size_t)(kblk * 128 + wid * 16) * ldw + n0; dst += kblk * 128 + wid * 16;
}
__device__ __forceinline__ bool weave_step(Weave& W, char* lds, LAS unsigned char* ldsl, int wid, int lane) {
    if (W.pend >= 0) {
        const float* src; int ldw, ldd, n0, isup, type; unsigned char* dst;
        weave_decode(W, W.pend, wid, src, ldw, dst, ldd, n0, isup, type);
        const float* land = (const float*)(lds + OFF_LAND + wid * 4096) + lane;
        float v[16];
#pragma unroll
        for (int i = 0; i < 16; ++i) v[i] = land[i * 64] * 32.f;
        u32x4 o; o.x = pk4_fp8(v[0], v[1], v[2], v[3]); o.y = pk4_fp8(v[4], v[5], v[6], v[7]); o.z = pk4_fp8(v[8], v[9], v[10], v[11]); o.w = pk4_fp8(v[12], v[13], v[14], v[15]);
        const int n = n0 + lane; const int drow = type < 2 ? (256 * (n >> 7) + 128 * isup + (n & 127)) : n;
#ifdef WEAVE_NT_STORE
        __builtin_nontemporal_store(o, (u32x4*)(dst + (size_t)drow * ldd));
#else
        *(GAS u32x4*)(dst + (size_t)drow * ldd) = o;
#endif
        asm volatile("s_waitcnt lgkmcnt(0)" ::: "memory");
        W.pend = -1;
    }
    if (W.next < W.end) {
        const float* src; int ldw, ldd, n0, isup, type; unsigned char* dst;
        weave_decode(W, W.next, wid, src, ldw, dst, ldd, n0, isup, type);
        const float* sp = src + (size_t)(lane >> 4) * ldw + (lane & 15) * 4;
#pragma unroll
        for (int i = 0; i < 4; ++i) __builtin_amdgcn_global_load_lds((const unsigned*)(sp + (size_t)(4 * i) * ldw), (LAS unsigned*)(ldsl + OFF_LAND + wid * 4096 + i * 1024), 16, 0, WEAVE_AUX);
        W.pend = W.next; ++W.next;
        return true;
    }
    return false;
}
__device__ __forceinline__ void attn_unit(const bf16_t* __restrict__ Qg, const bf16_t* __restrict__ Kg, const bf16_t* __restrict__ Vg, bf16_t* MIX,
                                          int b, int h, int qblk, float lam, const float* __restrict__ subg, char* lds, LAS unsigned char* ldsl, Weave& wv) {
    const int tid = threadIdx.x, wid = __builtin_amdgcn_readfirstlane(tid >> 6), lane = tid & 63, r32 = lane & 31, hi = lane >> 5;
    const int comp = wid >> 2, wq = wid & 3;
    float* wsf = (float*)(lds + OFF_WS) + wid * 64; float* li_l = wsf; float* al_l = wsf + 32;
    float* xch = (float*)(lds + OFF_XCH) + wq * 4096;
    const long tok0 = (long)b * SEQ;
    float mhat = 0.f, l_reg = 0; f32x16 o[4] = {}; bf16x8 qr[4];
    const bf16_t* Qw = Qg + (tok0 + qblk * 128 + wq * QBLK + r32) * 512 + h * 128 + comp * 64 + hi * 8;
#pragma unroll
    for (int d0 = 0; d0 < 4; ++d0) qr[d0] = *reinterpret_cast<const bf16x8*>(Qw + d0 * 16);
    const char* Kb = (const char*)(Kg + tok0 * 512 + h * 128); const char* Vb = (const char*)(Vg + tok0 * 512 + h * 128);
    unsigned koff[2], voff[2];
#pragma unroll
    for (int i = 0; i < 2; ++i) { const int p_ = (wid * 2 + i) * 1024 + 16 * lane;
        { const int row = p_ >> 8, colB = (p_ & 255) ^ ((row & 7) << 4); koff[i] = (unsigned)(row * 1024 + colB); }
        { const int sub = p_ >> 9, kk = (sub >> 2) * 8 + ((p_ & 511) >> 6), c = (sub & 3) * 32 + (((p_ & 511) >> 1) & 31);
          const int k = (kk & ~0xC) | ((kk & 4) << 1) | ((kk & 8) >> 1); voff[i] = (unsigned)(k * 1024 + c * 2); } }
    const int vb0 = (int)(uintptr_t)lds + v_rd_base(lane);
    const int kc0 = comp * 64;
#define DMA_TILE(t, so) do { const char* kb_ = Kb + (size_t)(t) * (KVBLK * 1024); const char* vb_ = Vb + (size_t)(t) * (KVBLK * 1024); \
    _Pragma("unroll") for (int i_ = 0; i_ < 2; ++i_) { \
        __builtin_amdgcn_global_load_lds((const unsigned*)(vb_ + voff[i_]), (LAS unsigned*)(ldsl + (so) + (wid * 2 + i_) * 1024), 16, 0, 0); \
        __builtin_amdgcn_global_load_lds((const unsigned*)(kb_ + koff[i_]), (LAS unsigned*)(ldsl + (so) + SHM_V + (wid * 2 + i_) * 1024), 16, 0, 0); } } while (0)
#define WAIT_BAR(N) asm volatile("s_waitcnt vmcnt(" #N ") lgkmcnt(0)\n\ts_barrier" ::: "memory")
#define RESC(a) do { if (__any((a) < 1.f)) { if (hi == 0) al_l[r32] = (a); asm volatile("s_waitcnt lgkmcnt(0)" ::: "memory"); \
    _Pragma("unroll") for (int d = 0; d < 4; ++d) _Pragma("unroll") for (int r = 0; r < 16; ++r) o[d][r] *= al_l[crow(r, hi)]; } } while (0)
    f32x16 pA0, pA1, pB0, pB1; float alA, alB; bf16x8 pa0, pa1, pa2, pa3; constexpr int NT = SEQ / KVBLK;
    DMA_TILE(0, 0); DMA_TILE(1, SLOT);
    WAIT_BAR(4);
    qkt(pA0, pA1, lds + SHM_V, qr, mhat, r32, hi, kc0); partialSM<true>(pA0, pA1, mhat, alA);
    DMA_TILE(2, 2 * SLOT);
    WAIT_BAR(4);
    int s_prev = 0, s_cur = SLOT, s_next = 2 * SLOT;
#define ROT() do { const int t_ = s_prev; s_prev = s_cur; s_cur = s_next; s_next = t_; } while (0)
    bool hot = false;
    for (int j = 1; j + 1 < NT; j += 2) {
        SBAR(); qkt(pB0, pB1, lds + s_cur + SHM_V, qr, mhat, r32, hi, kc0);
        finishSM(pA0, pA1, alA, l_reg, pa0, pa1, pa2, pa3); SBAR();
        pv_sm(o, vb0 + s_prev, pa0, pa1, pa2, pa3, pB0, pB1, mhat, alB);
        if (hot) WAIT_BAR(4); else WAIT_BAR(0);
        if (j + 2 < NT) DMA_TILE(j + 2, s_prev);
        RESC(alB); ROT();
        SBAR(); qkt(pA0, pA1, lds + s_cur + SHM_V, qr, mhat, r32, hi, kc0);
        finishSM(pB0, pB1, alB, l_reg, pa0, pa1, pa2, pa3); SBAR();
        pv_sm(o, vb0 + s_prev, pa0, pa1, pa2, pa3, pA0, pA1, mhat, alA);
        WAIT_BAR(0);
        if (j + 3 < NT) DMA_TILE(j + 3, s_prev);
#ifndef PROBE_WEAVE_OFF
        hot = weave_step(wv, lds, ldsl, wid, lane);
#endif
        RESC(alA); ROT();
    }
    SBAR(); qkt(pB0, pB1, lds + s_cur + SHM_V, qr, mhat, r32, hi, kc0);
    finishSM(pA0, pA1, alA, l_reg, pa0, pa1, pa2, pa3); SBAR();
    pv_sm(o, vb0 + s_prev, pa0, pa1, pa2, pa3, pB0, pB1, mhat, alB);
    RESC(alB);
    finishSM(pB0, pB1, alB, l_reg, pa0, pa1, pa2, pa3); SBAR();
    pv_d0(o, vb0 + s_cur, pa0, pa1, pa2, pa3);
    asm volatile("s_waitcnt lgkmcnt(0)\n\ts_barrier" ::: "memory");
    if (hi == 0) li_l[r32] = l_reg; asm volatile("s_waitcnt lgkmcnt(0)" ::: "memory");
    float rli[16];
#pragma unroll
    for (int r = 0; r < 16; ++r) rli[r] = __builtin_amdgcn_rcpf(li_l[crow(r, hi)]);
    if (comp == 1) {
#pragma unroll
        for (int d0 = 0; d0 < 4; ++d0)
#pragma unroll
            for (int r = 0; r < 16; ++r) xch[(d0 * 16 + r) * 64 + lane] = o[d0][r] * rli[r];
    }
    __syncthreads();
    if (comp == 0) {
        float rn[16];
#pragma unroll
        for (int r = 0; r < 16; ++r) { float s = 0.f;
#pragma unroll
            for (int d0 = 0; d0 < 4; ++d0) { const float v = o[d0][r] * rli[r] - lam * xch[(d0 * 16 + r) * 64 + lane]; o[d0][r] = v; s += v * v; }
            s += __shfl_xor(s, 1); s += __shfl_xor(s, 2); s += __shfl_xor(s, 4); s += __shfl_xor(s, 8); s += __shfl_xor(s, 16);
            rn[r] = __builtin_amdgcn_rsqf(s * (1.f / 128.f) + RMS_EPS) * 0.8f; }
        float gs[4];
#pragma unroll
        for (int d0 = 0; d0 < 4; ++d0) gs[d0] = subg[d0 * 32 + r32];
        asm volatile("s_waitcnt lgkmcnt(0)" ::: "memory");
        bf16_t* stg = (bf16_t*)xch;
#pragma unroll
        for (int r = 0; r < 16; ++r) { const int orow = crow(r, hi);
#pragma unroll
            for (int d0 = 0; d0 < 4; ++d0) stg[orow * 128 + d0 * 32 + r32] = (bf16_t)f2bf(o[d0][r] * rn[r] * gs[d0]); }
        asm volatile("s_waitcnt lgkmcnt(0)" ::: "memory");
        bf16_t* Ow = MIX + (tok0 + qblk * 128 + wq * QBLK) * 1024 + h * 128;
#pragma unroll
        for (int i = 0; i < 8; ++i) { const int row = i * 4 + (lane >> 4), ch = lane & 15; const u32x4 v = *(const u32x4*)(stg + row * 128 + ch * 8); *(u32x4*)(Ow + (long)row * 1024 + ch * 8) = v; }
    }
    asm volatile("s_waitcnt lgkmcnt(0)" ::: "memory");
    __syncthreads();
#undef DMA_TILE
#undef WAIT_BAR
#undef ROT
#undef RESC
}
#undef KSWZ
}

struct Params {
    const float *x, *c, *w_ada, *b_ada, *norm1_g, *w_in, *lq1, *lk1, *lq2, *lk2, *subln_g, *w_pool, *pool_scale, *w_out, *norm2_g, *w_rg, *b_rg, *w_re, *b_re, *w_gate, *w_up, *w_down, *final_g;
    float* out; unsigned char* ws; long long ph;
};
struct Frame { LAS unsigned char* lds; int tid, lane, wave, vcu, G; };

__device__ __forceinline__ void transpose_item(const float* W, int ldw, int k0, int n0, bf16_t* WT, size_t drow0, int ldd, int dcol0, LAS float* scr, int lane) {
#pragma unroll 8
    for (int i = 0; i < 32; ++i) { const int kk = 2 * i + (lane >> 5); scr[kk * 33 + (lane & 31)] = W[(size_t)(k0 + kk) * ldw + n0 + (lane & 31)]; }
    LDS_WAIT(); asm volatile("" ::: "memory");
    const int c = lane & 7;
#pragma unroll
    for (int j = 0; j < 4; ++j) { const int n = (lane >> 3) + 8 * j; const LAS float* s = scr + (8 * c) * 33 + n;
        u32x4 o; o.x = cvt_pk_bf16(s[0 * 33], s[1 * 33]); o.y = cvt_pk_bf16(s[2 * 33], s[3 * 33]); o.z = cvt_pk_bf16(s[4 * 33], s[5 * 33]); o.w = cvt_pk_bf16(s[6 * 33], s[7 * 33]);
        *(GAS u32x4*)(WT + (drow0 + n) * (size_t)ldd + dcol0 + 8 * c) = o; }
    LDS_WAIT(); asm volatile("" ::: "memory");
}
__device__ __forceinline__ void transpose_item_f8(const float* W, int ldw, int k0, int n0, unsigned char* WT, size_t drow0, int ldd, int dcol0, LAS float* scr, int lane) {
#pragma unroll 8
    for (int i = 0; i < 32; ++i) { const int kk = 2 * i + (lane >> 5); scr[kk * 33 + (lane & 31)] = W[(size_t)(k0 + kk) * ldw + n0 + (lane & 31)] * 32.f; }
    LDS_WAIT(); asm volatile("" ::: "memory");
    const int c = lane & 3;
#pragma unroll
    for (int j = 0; j < 2; ++j) { const int n = (lane >> 2) + 16 * j; const LAS float* s = scr + (16 * c) * 33 + n;
        u32x4 o; o.x = pk4_fp8(s[0 * 33], s[1 * 33], s[2 * 33], s[3 * 33]); o.y = pk4_fp8(s[4 * 33], s[5 * 33], s[6 * 33], s[7 * 33]);
        o.z = pk4_fp8(s[8 * 33], s[9 * 33], s[10 * 33], s[11 * 33]); o.w = pk4_fp8(s[12 * 33], s[13 * 33], s[14 * 33], s[15 * 33]);
        *(GAS u32x4*)(WT + (drow0 + n) * (size_t)ldd + dcol0 + 16 * c) = o; }
    LDS_WAIT(); asm volatile("" ::: "memory");
}
__device__ __forceinline__ void p0_prologue(const Params& P, Frame& F) {
    LAS float* scr = (LAS float*)(F.lds + F.wave * 16384);
    const int gw = F.vcu * NWAVES + F.wave, NGW = F.G * NWAVES, lane = F.lane;
    unsigned char* ws = P.ws;
    constexpr int T_MOD = 768, T_WF = 512, T_ROPE = 256, T_WR = 768, I_WIN = 1024, I_WOUT = 256;
    constexpr int NITEMS = T_MOD + T_WF + T_ROPE + T_WR + I_WIN + I_WOUT;
    for (int it = gw; it < NITEMS; it += NGW) {
        int r = it;
        if (r < T_MOD) {
            const int nc = r >> 3, kq = r & 7, n0 = nc * 64;
            for (int idx = lane; idx < 2048; idx += 64) { const int b = idx & 15, kk = idx >> 4; const float v = P.c[b * DM + kq * 128 + kk]; scr[kk * 16 + b] = v / (1.f + __expf(-v)); }
            LDS_WAIT(); asm volatile("" ::: "memory");
            float acc[16];
#pragma unroll
            for (int b = 0; b < 16; ++b) acc[b] = 0.f;
            const float* wp = P.w_ada + (size_t)(kq * 128) * 6144 + n0 + lane;
#pragma unroll 8
            for (int kk = 0; kk < 128; ++kk) { const float w = wp[(size_t)kk * 6144];
#pragma unroll
                for (int b4 = 0; b4 < 4; ++b4) { const f32x4 s = *(const LAS f32x4*)(scr + kk * 16 + b4 * 4); acc[b4 * 4 + 0] += w * s[0]; acc[b4 * 4 + 1] += w * s[1]; acc[b4 * 4 + 2] += w * s[2]; acc[b4 * 4 + 3] += w * s[3]; } }
            float* mp = (float*)(ws + WS_MODP) + (size_t)(kq * 16) * 6144 + n0 + lane;
#pragma unroll
            for (int b = 0; b < 16; ++b) mp[(size_t)b * 6144] = acc[b];
            LDS_WAIT(); asm volatile("" ::: "memory");
            continue; }
        r -= T_MOD;
        if (r < T_WF) {
            const int g = r >> 7, cc = (r >> 4) & 7, nc = r & 15, c0 = cc * 16, n0 = nc * 64;
            for (int idx = lane; idx < 2048; idx += 64) { const int d = idx & 127, c = idx >> 7; scr[d * 16 + c] = P.w_pool[(size_t)(g * 128 + c0 + c) * 128 + d] * P.pool_scale[g * 128 + d]; }
            LDS_WAIT(); asm volatile("" ::: "memory");
            float acc[16];
#pragma unroll
            for (int c = 0; c < 16; ++c) acc[c] = 0.f;
            const float* wp = P.w_out + (size_t)(512 + g * 128) * DM + n0 + lane;
#pragma unroll 8
            for (int d = 0; d < 128; ++d) { const float w = wp[(size_t)d * DM];
#pragma unroll
                for (int c4 = 0; c4 < 4; ++c4) { const f32x4 s = *(const LAS f32x4*)(scr + d * 16 + c4 * 4); acc[c4 * 4 + 0] += w * s[0]; acc[c4 * 4 + 1] += w * s[1]; acc[c4 * 4 + 2] += w * s[2]; acc[c4 * 4 + 3] += w * s[3]; } }
            bf16_t* dst = (bf16_t*)(ws + WS_WMIX) + (size_t)(n0 + lane) * DM + 512 + g * 128 + c0;
            u32x4 o0, o1; o0.x = pk2(acc[0], acc[1]); o0.y = pk2(acc[2], acc[3]); o0.z = pk2(acc[4], acc[5]); o0.w = pk2(acc[6], acc[7]);
            o1.x = pk2(acc[8], acc[9]); o1.y = pk2(acc[10], acc[11]); o1.z = pk2(acc[12], acc[13]); o1.w = pk2(acc[14], acc[15]);
            *(GAS u32x4*)dst = o0; *(GAS u32x4*)(dst + 8) = o1;
            LDS_WAIT(); asm volatile("" ::: "memory");
            continue; }
        r -= T_WF;
        if (r < T_ROPE) {
            const int idx = r * 64 + lane, pos = idx >> 3, j = idx & 7;
            const float invf = (float)exp(-(double)j * 1.640295422175541);
            const float ang = (float)pos * invf;
            const double rev = (double)ang * 0.15915494309189535; const float fr = (float)(rev - floor(rev));
            float* rp = (float*)(ws + WS_ROPE) + (size_t)pos * 16;
            rp[j] = __builtin_amdgcn_cosf(fr); rp[8 + j] = __builtin_amdgcn_sinf(fr);
            continue; }
        r -= T_ROPE;
        if (r < T_WR) {
            const int n = r >> 4, k = (r & 15) * 64 + lane;
            const float v = n < 4 ? P.w_rg[k * 4 + n] : (n < 36 ? P.w_re[k * 32 + (n - 4)] : 0.f);
            const unsigned hb = f2bf(v); const float lo = v - bf2f((unsigned short)hb);
            ((bf16_t*)(ws + WS_WRHI))[n * DM + k] = (bf16_t)hb; ((bf16_t*)(ws + WS_WRLO))[n * DM + k] = (bf16_t)f2bf(lo);
            continue; }
        r -= T_WR;
        if (r < I_WIN) { const int kb = r >> 6, nb = r & 63; transpose_item(P.w_in, 2048, kb * 64, nb * 32, (bf16_t*)(ws + WS_WIN), (size_t)nb * 32, DM, kb * 64, scr, lane); continue; }
        r -= I_WIN;
        { const int kb = r >> 5, nb = r & 31; transpose_item(P.w_out, DM, kb * 64, nb * 32, (bf16_t*)(ws + WS_WMIX), (size_t)nb * 32, DM, kb * 64, scr, lane); }
    }
}
__device__ __forceinline__ void p1_norm1(const Params& P, Frame& F) {
    const int gw = F.vcu * NWAVES + F.wave, NGW = F.G * NWAVES, lane = F.lane;
    unsigned char* ws = P.ws;
    const float* modp = (const float*)(ws + WS_MODP);
    for (int t = gw; t < 1536; t += NGW) {
        const int idx = t * 64 + lane, b = idx / 6144, n = idx - b * 6144;
        float v = P.b_ada[n];
#pragma unroll
        for (int kq = 0; kq < 8; ++kq) v += modp[(size_t)(kq * 16 + b) * 6144 + n];
        ((float*)(ws + WS_MODF))[idx] = v;
        if ((n >> 10) == 4) ((float*)(ws + WS_GM2))[b * DM + (n & 1023)] = P.norm2_g[n & 1023] * (1.f + v);
    }
    bf16_t* H1 = (bf16_t*)(ws + WS_H1);
    for (int g16 = gw; g16 < NTOK / 16; g16 += NGW) {
        const int row0 = g16 * 16, b = row0 >> 11;
        f32x4 gm[4], sh[4];
#pragma unroll
        for (int j = 0; j < 4; ++j) { const int col = 4 * lane + 256 * j;
            f32x4 s0 = *(const f32x4*)(P.b_ada + col), s1 = *(const f32x4*)(P.b_ada + 1024 + col);
#pragma unroll
            for (int kq = 0; kq < 8; ++kq) { const float* mp = modp + (size_t)(kq * 16 + b) * 6144 + col; s0 += *(const f32x4*)mp; s1 += *(const f32x4*)(mp + 1024); }
            sh[j] = s0; gm[j] = *(const f32x4*)(P.norm1_g + col) * (1.f + s1); }
        for (int rb = 0; rb < 16; rb += 4) {
            f32x4 v[4][4]; float s[4];
#pragma unroll
            for (int q = 0; q < 4; ++q) { const GAS f32x4* xr = (const GAS f32x4*)(P.x + (size_t)(row0 + rb + q) * DM) + lane;
#pragma unroll
                for (int j = 0; j < 4; ++j) v[q][j] = xr[64 * j]; }
#pragma unroll
            for (int q = 0; q < 4; ++q) { float a = 0.f;
#pragma unroll
                for (int j = 0; j < 4; ++j) a += (v[q][j].x * v[q][j].x + v[q][j].y * v[q][j].y) + (v[q][j].z * v[q][j].z + v[q][j].w * v[q][j].w);
                s[q] = a; }
#pragma unroll
            for (int q = 0; q < 4; ++q) s[q] = __builtin_amdgcn_rsqf(wave_sum(s[q]) * (1.f / DM) + RMS_EPS);
#pragma unroll
            for (int q = 0; q < 4; ++q) { GAS u32x2* o8 = (GAS u32x2*)(H1 + (size_t)(row0 + rb + q) * DM) + lane;
#pragma unroll
                for (int j = 0; j < 4; ++j) { const f32x4 hh = v[q][j] * s[q] * gm[j] + sh[j]; u32x2 w; w.x = cvt_pk_bf16(hh.x, hh.y); w.y = cvt_pk_bf16(hh.z, hh.w); o8[64 * j] = w; } }
        }
    }
}
__device__ __forceinline__ void p3_pooldiff(const Params& P, Frame& F) {
    const int gw = F.vcu * NWAVES + F.wave, NGW = F.G * NWAVES, lane = F.lane;
    const bf16_t* U = (const bf16_t*)(P.ws + WS_U); bf16_t* MIX = (bf16_t*)(P.ws + WS_MIXIN);
    const int g = lane >> 4, left = 1 << g, right = (1 << g) - 1;
    for (int t = gw; t < NTOK / 16; t += NGW) {
        const int row0 = t * 16, b = row0 >> 11, p0 = row0 & (SEQ - 1);
        const bf16_t* ub = U + (size_t)b * SEQ * 512 + lane * 8;
        float sum[8];
#pragma unroll
        for (int j = 0; j < 8; ++j) sum[j] = 0.f;
        { bf16x8 wv_[16];
#pragma unroll
          for (int q = 0; q < 16; ++q) { const int dj = q - 8, pj = p0 + dj; const bool in = dj >= -left && dj <= right && pj >= 0 && pj < SEQ;
              wv_[q] = in ? *(const bf16x8*)(ub + (size_t)pj * 512) : (bf16x8){0, 0, 0, 0, 0, 0, 0, 0}; }
#pragma unroll
          for (int q = 0; q < 16; ++q)
#pragma unroll
              for (int j = 0; j < 8; ++j) sum[j] += bf2f((unsigned short)wv_[q][j]); }
#pragma unroll
        for (int hb_ = 0; hb_ < 2; ++hb_) {
            bf16x8 cv[8], av[8], sv[8];
#pragma unroll
            for (int q = 0; q < 8; ++q) { const int p = p0 + hb_ * 8 + q, pa = p + 1 + right, ps = p - left;
                cv[q] = *(const bf16x8*)(ub + (size_t)p * 512);
                av[q] = pa < SEQ ? *(const bf16x8*)(ub + (size_t)pa * 512) : (bf16x8){0, 0, 0, 0, 0, 0, 0, 0};
                sv[q] = ps >= 0 ? *(const bf16x8*)(ub + (size_t)ps * 512) : (bf16x8){0, 0, 0, 0, 0, 0, 0, 0}; }
#pragma unroll
            for (int q = 0; q < 8; ++q) { const int p = p0 + hb_ * 8 + q;
                const int lo = p - left < 0 ? 0 : p - left, hi = p + right + 1 > SEQ ? SEQ : p + right + 1;
                const float inv = 1.f / (float)(hi - lo);
                float d[8];
#pragma unroll
                for (int j = 0; j < 8; ++j) d[j] = sum[j] * inv - bf2f((unsigned short)cv[q][j]);
                u32x4 w; w.x = cvt_pk_bf16(d[0], d[1]); w.y = cvt_pk_bf16(d[2], d[3]); w.z = cvt_pk_bf16(d[4], d[5]); w.w = cvt_pk_bf16(d[6], d[7]);
                *(u32x4*)(MIX + (size_t)(b * SEQ + p) * DM + 512 + lane * 8) = w;
#pragma unroll
                for (int j = 0; j < 8; ++j) sum[j] += bf2f((unsigned short)av[q][j]) - bf2f((unsigned short)sv[q][j]); }
        }
    }
}
#define EXPAND_BF(A, C, Dq) do { (A).x = __builtin_bit_cast(float, (Dq).x << 16); (A).y = __builtin_bit_cast(float, (Dq).x & 0xffff0000u); (A).z = __builtin_bit_cast(float, (Dq).y << 16); (A).w = __builtin_bit_cast(float, (Dq).y & 0xffff0000u); \
    (C).x = __builtin_bit_cast(float, (Dq).z << 16); (C).y = __builtin_bit_cast(float, (Dq).z & 0xffff0000u); (C).z = __builtin_bit_cast(float, (Dq).w << 16); (C).w = __builtin_bit_cast(float, (Dq).w & 0xffff0000u); } while (0)
__device__ __forceinline__ void p5_norm2_route(const Params& P, Frame& F, const int reps) {
    const int lane = F.lane, rr = lane & 15, kq = lane >> 4, kw = F.wave;
    unsigned char* ws = P.ws;
    LAS float* L_GM = (LAS float*)(F.lds); LAS float* L_SH = (LAS float*)(F.lds + 4096);
    LAS float* ssqp = (LAS float*)(F.lds + 8192);
    LAS float* L_BI = (LAS float*)(F.lds + 8192 + 1024);
    LAS float* lgp = (LAS float*)(F.lds + 12288);
    LAS int* rres = (LAS int*)(F.lds + 36864);
    LAS int* hist = (LAS int*)(F.lds + TB_HIST); LAS int* hb = (LAS int*)(F.lds + TB_HB);
    const float* gm2 = (const float*)(ws + WS_GM2); const float* modf = (const float*)(ws + WS_MODF);
    const bf16_t* wrhi = (const bf16_t*)(ws + WS_WRHI); const bf16_t* wrlo = (const bf16_t*)(ws + WS_WRLO);
    unsigned char* H2 = ws + WS_H2;
    int* rinfo = (int*)(ws + WS_RINFO); float* rw = (float*)(ws + WS_RW);
    gu32* cnt = (gu32*)(ws + WS_CTL) + CW_CNT;
    const int colb = kw * 128 + kq * 8;
    bf16x8 bhi[4][3], blo[4][3];
#pragma unroll
    for (int ks = 0; ks < 4; ++ks)
#pragma unroll
        for (int nb = 0; nb < 3; ++nb) { bhi[ks][nb] = *(const bf16x8*)(wrhi + (size_t)(nb * 16 + rr) * DM + colb + ks * 32); blo[ks][nb] = *(const bf16x8*)(wrlo + (size_t)(nb * 16 + rr) * DM + colb + ks * 32); }
    for (int rp_ = 0; rp_ < reps; ++rp_) { const bool dry = rp_ + 1 < reps;
    for (int blk = F.vcu; blk < NTOK / 128; blk += F.G) {
        const int b = (blk * 128) >> 11;
        if (F.tid < 256) { *(LAS f32x4*)(L_GM + 4 * F.tid) = *(const f32x4*)(gm2 + (size_t)b * DM + 4 * F.tid); *(LAS f32x4*)(L_SH + 4 * F.tid) = *(const f32x4*)(modf + (size_t)b * 6144 + 3 * 1024 + 4 * F.tid); }
        if (F.tid < 32) hist[F.tid] = 0;
        if (F.tid >= 64 && F.tid < 100) L_BI[F.tid - 64] = (F.tid < 68) ? P.b_rg[F.tid - 64] : P.b_re[F.tid - 68];
        const bf16_t* xbase = (const bf16_t*)(ws + WS_X1) + (size_t)(blk * 128 + rr) * DM + colb;
        f32x4 xa[4], xc[4]; u32x4 xl[4];
#pragma unroll
        for (int ks = 0; ks < 4; ++ks) xl[ks] = *(const u32x4*)(xbase + ks * 32);
        __syncthreads();
        for (int it = 0; it < 8; ++it) {
            const int row0 = blk * 128 + it * 16;
            float ssq = 0.f;
#pragma unroll
            for (int ks = 0; ks < 4; ++ks) { EXPAND_BF(xa[ks], xc[ks], xl[ks]); const f32x4 a = xa[ks], c = xc[ks]; ssq += (a.x * a.x + a.y * a.y) + (a.z * a.z + a.w * a.w) + (c.x * c.x + c.y * c.y) + (c.z * c.z + c.w * c.w); }
            ssq += __shfl_xor(ssq, 16); ssq += __shfl_xor(ssq, 32);
            if (kq == 0) ssqp[kw * 16 + rr] = ssq;
            __syncthreads();
            float tot = 0.f;
#pragma unroll
            for (int w = 0; w < 8; ++w) tot += ssqp[w * 16 + rr];
            const float rstd = __builtin_amdgcn_rsqf(tot * (1.f / DM) + RMS_EPS);
            f32x4 acc[3] = {{0.f, 0.f, 0.f, 0.f}, {0.f, 0.f, 0.f, 0.f}, {0.f, 0.f, 0.f, 0.f}};
            unsigned char* hrow = H2 + (size_t)(row0 + rr) * DM + colb;
            const bf16_t* xnext = xbase + (size_t)(it + 1) * 16 * DM;
#pragma unroll
            for (int ks = 0; ks < 4; ++ks) {
                const f32x4 g0 = *(const LAS f32x4*)(L_GM + colb + ks * 32), g1 = *(const LAS f32x4*)(L_GM + colb + ks * 32 + 4);
                const f32x4 s0 = *(const LAS f32x4*)(L_SH + colb + ks * 32), s1 = *(const LAS f32x4*)(L_SH + colb + ks * 32 + 4);
                const f32x4 h0 = xa[ks] * rstd * g0 + s0, h1 = xc[ks] * rstd * g1 + s1;
                if (it < 7) xl[ks] = *(const u32x4*)(xnext + ks * 32);
                u32x4 whi; whi.x = cvt_pk_bf16(h0.x, h0.y); whi.y = cvt_pk_bf16(h0.z, h0.w); whi.z = cvt_pk_bf16(h1.x, h1.y); whi.w = cvt_pk_bf16(h1.z, h1.w);
                f32x4 l0, l1;
                l0.x = h0.x - __builtin_bit_cast(float, whi.x << 16); l0.y = h0.y - __builtin_bit_cast(float, whi.x & 0xffff0000u);
                l0.z = h0.z - __builtin_bit_cast(float, whi.y << 16); l0.w = h0.w - __builtin_bit_cast(float, whi.y & 0xffff0000u);
                l1.x = h1.x - __builtin_bit_cast(float, whi.z << 16); l1.y = h1.y - __builtin_bit_cast(float, whi.z & 0xffff0000u);
                l1.z = h1.z - __builtin_bit_cast(float, whi.w << 16); l1.w = h1.w - __builtin_bit_cast(float, whi.w & 0xffff0000u);
                u32x4 wlo; wlo.x = cvt_pk_bf16(l0.x, l0.y); wlo.y = cvt_pk_bf16(l0.z, l0.w); wlo.z = cvt_pk_bf16(l1.x, l1.y); wlo.w = cvt_pk_bf16(l1.z, l1.w);
                { u32x2 w8; w8.x = pk4_fp8(h0.x, h0.y, h0.z, h0.w); w8.y = pk4_fp8(h1.x, h1.y, h1.z, h1.w); *(u32x2*)(hrow + ks * 32) = w8; }
                const bf16x8 ahi = __builtin_bit_cast(bf16x8, whi), alo = __builtin_bit_cast(bf16x8, wlo);
#pragma unroll
                for (int nb = 0; nb < 3; ++nb) {
                    acc[nb] = __builtin_amdgcn_mfma_f32_16x16x32_bf16(ahi, bhi[ks][nb], acc[nb], 0, 0, 0);
                    acc[nb] = __builtin_amdgcn_mfma_f32_16x16x32_bf16(alo, bhi[ks][nb], acc[nb], 0, 0, 0);
                    acc[nb] = __builtin_amdgcn_mfma_f32_16x16x32_bf16(ahi, blo[ks][nb], acc[nb], 0, 0, 0);
                }
            }
            LAS float* lgw = lgp + kw * 768;
#pragma unroll
            for (int nb = 0; nb < 3; ++nb)
#pragma unroll
                for (int r = 0; r < 4; ++r) lgw[(kq * 4 + r) * 48 + nb * 16 + rr] = acc[nb][r];
            __syncthreads();
            if (kw == it && lane < 16) {
                const LAS float* L = lgp + lane * 48;
#define LG(j) (((L[(j)] + L[768 + (j)]) + (L[1536 + (j)] + L[2304 + (j)])) + ((L[3072 + (j)] + L[3840 + (j)]) + (L[4608 + (j)] + L[5376 + (j)])))
                float gl[4]; int gs = 0; float gmx;
#pragma unroll
                for (int j = 0; j < 4; ++j) gl[j] = LG(j) + L_BI[j];
                gmx = gl[0];
#pragma unroll
                for (int j = 1; j < 4; ++j) if (gl[j] > gmx) { gmx = gl[j]; gs = j; }
                float gden = 0.f;
#pragma unroll
                for (int j = 0; j < 4; ++j) gden += __expf(gl[j] - gmx);
                const float gpv = 1.f / gden;
                float el[8];
#pragma unroll
                for (int j = 0; j < 8; ++j) el[j] = LG(4 + gs * 8 + j) + L_BI[4 + gs * 8 + j];
#undef LG
                int i0 = 0; float m0 = el[0];
#pragma unroll
                for (int j = 1; j < 8; ++j) if (el[j] > m0) { m0 = el[j]; i0 = j; }
                int i1 = -1; float m1 = -3.0e38f;
#pragma unroll
                for (int j = 0; j < 8; ++j) if (j != i0 && el[j] > m1) { m1 = el[j]; i1 = j; }
                const float tt = __expf(m1 - m0), den = 1.f / (1.f + tt);
                const int e0 = gs * 8 + i0, e1 = gs * 8 + i1;
                int lr0 = 0, lr1 = 0;
                if (!dry) { lr0 = atomicAdd((int*)(hist + e0), 1); lr1 = atomicAdd((int*)(hist + e1), 1); }
                LAS int* rp = rres + (it * 16 + lane) * 6;
                rp[0] = e0; rp[1] = e1; rp[2] = __builtin_bit_cast(int, gpv * den); rp[3] = __builtin_bit_cast(int, gpv * tt * den); rp[4] = lr0; rp[5] = lr1;
            }
        }
        __syncthreads();
        if (F.tid < 32 && !dry) { const int hc = hist[F.tid]; hb[F.tid] = hc ? (int)__hip_atomic_fetch_add(cnt + 64 * F.tid, (unsigned)hc, __ATOMIC_RELAXED, __HIP_MEMORY_SCOPE_AGENT) : 0; }
        __syncthreads();
        if (F.tid < 128 && !dry) { const LAS int* rp = rres + F.tid * 6; const int tok = blk * 128 + F.tid;
            const int e0 = rp[0], e1 = rp[1];
            const int p0 = e0 * ECAP + hb[e0] + rp[4], p1 = e1 * ECAP + hb[e1] + rp[5];
            rinfo[p0] = tok * 2; rw[p0] = __builtin_bit_cast(float, rp[2]); rinfo[p1] = tok * 2 + 1; rw[p1] = __builtin_bit_cast(float, rp[3]); }
        __syncthreads();
    }
    }
}
__device__ __forceinline__ int p6_tables(const Params& P, Frame& F) {
    LAS int* rt_e = (LAS int*)(F.lds + TB_RTE); LAS int* rtb = (LAS int*)(F.lds + TB_RTB); LAS int* cs = (LAS int*)(F.lds + TB_CNT);
    gu32* cnt = (gu32*)(P.ws + WS_CTL) + CW_CNT;
    if (F.tid < 32) cs[F.tid] = (int)__hip_atomic_load(cnt + 64 * F.tid, __ATOMIC_RELAXED, __HIP_MEMORY_SCOPE_AGENT);
    __syncthreads();
    if (F.tid == 0) { int a = 0; for (int e = 0; e < NEXP; ++e) { rtb[e] = a; a += (cs[e] + 255) >> 8; } rtb[NEXP] = a; }
    __syncthreads();
    const int nrt = rtb[NEXP];
    if (F.tid < nrt && F.tid < 320) { int e = 0; for (int j = 1; j < NEXP; ++j) e += (rtb[j] <= F.tid) ? 1 : 0; rt_e[F.tid] = e; }
    __syncthreads();
    return nrt;
}
__device__ __forceinline__ void p6_rowlists(const Params& P, Frame& F, const gm::MoeOrder& S) {
    LAS int* tokrow = (LAS int*)(F.lds + TB_TOK); LAS float* wrow = (LAS float*)(F.lds + TB_W); LAS int* cs = (LAS int*)(F.lds + TB_CNT);
    const int* rinfo = (const int*)(P.ws + WS_RINFO); const float* rw = (const float*)(P.ws + WS_RW);
    if (F.tid < 256) {
        int ti[MAXU]; float tw[MAXU]; bool have[MAXU];
#pragma unroll
        for (int li = 0; li < MAXU; ++li) { gm::Unit u; have[li] = S.next(li, u); ti[li] = -1; tw[li] = 0.f;
            if (have[li]) { const int idx = u.mt * 256 + F.tid; if (idx < cs[u.e]) { ti[li] = rinfo[(size_t)u.e * ECAP + idx]; tw[li] = rw[(size_t)u.e * ECAP + idx]; } } }
#pragma unroll
        for (int li = 0; li < MAXU; ++li) if (have[li]) { tokrow[li * 256 + F.tid] = ti[li]; wrow[li * 256 + F.tid] = tw[li]; }
    }
    __syncthreads();
}
__device__ __forceinline__ void p8_final(const Params& P, Frame& F, float* dst) {
    const int gw = F.vcu * NWAVES + F.wave, NGW = F.G * NWAVES, lane = F.lane;
    const unsigned char* YS = P.ws + WS_YS; const float* modf = (const float*)(P.ws + WS_MODF);
    f32x4 fg[4];
#pragma unroll
    for (int j = 0; j < 4; ++j) fg[j] = *(const f32x4*)(P.final_g + 4 * lane + 256 * j);
    for (int g16 = gw; g16 < NTOK / 16; g16 += NGW) {
        const int row0 = g16 * 16, b = row0 >> 11;
        f32x4 g2[4];
#pragma unroll
        for (int j = 0; j < 4; ++j) g2[j] = *(const f32x4*)(modf + (size_t)b * 6144 + 5 * 1024 + 4 * lane + 256 * j);
        for (int rr = 0; rr < 16; ++rr) {
            const int row = row0 + rr;
            const GAS u32x2* xr = (const GAS u32x2*)((const bf16_t*)(P.ws + WS_X1) + (size_t)row * DM) + lane;
            const GAS unsigned* ya = (const GAS unsigned*)(YS + (size_t)(2 * row) * DM) + lane; const GAS unsigned* yb = (const GAS unsigned*)(YS + (size_t)(2 * row + 1) * DM) + lane;
            f32x4 v[4]; float s = 0.f;
#pragma unroll
            for (int j = 0; j < 4; ++j) { const u32x2 dq = xr[64 * j]; const unsigned a = ya[64 * j], c = yb[64 * j];
                f32x4 xv; xv.x = __builtin_bit_cast(float, dq.x << 16); xv.y = __builtin_bit_cast(float, dq.x & 0xffff0000u); xv.z = __builtin_bit_cast(float, dq.y << 16); xv.w = __builtin_bit_cast(float, dq.y & 0xffff0000u);
                const f32x2 a0 = __builtin_amdgcn_cvt_pk_f32_fp8((int)a, false), a1 = __builtin_amdgcn_cvt_pk_f32_fp8((int)a, true), c0 = __builtin_amdgcn_cvt_pk_f32_fp8((int)c, false), c1 = __builtin_amdgcn_cvt_pk_f32_fp8((int)c, true);
                f32x4 y; y.x = a0.x + c0.x; y.y = a0.y + c0.y; y.z = a1.x + c1.x; y.w = a1.y + c1.y;
                v[j] = xv + g2[j] * (y * 0.0625f); s += (v[j].x * v[j].x + v[j].y * v[j].y) + (v[j].z * v[j].z + v[j].w * v[j].w); }
            const float rstd = __builtin_amdgcn_rsqf(wave_sum(s) * (1.f / DM) + RMS_EPS);
#pragma unroll
            for (int j = 0; j < 4; ++j) ((GAS f32x4*)(dst + (size_t)row * DM) + lane)[64 * j] = v[j] * rstd * fg[j];
        }
    }
}

__device__ __forceinline__ void ph2_inproj(const Params& P, Frame& F) {
    unsigned char* ws = P.ws;
    gm::DenseOrder S; S.init(ws + WS_H1, ws + WS_WIN, NTOK, 2048, DM, F.G, (int)blockIdx.x);
    gm::EpiQKVU E{(bf16_t*)(ws + WS_Q), (bf16_t*)(ws + WS_K), (bf16_t*)(ws + WS_V), (bf16_t*)(ws + WS_U), (const float*)(ws + WS_ROPE)};
    gm::gemm_phase<gm::EpiQKVU, gm::DenseOrder>(F.lds, S, E);
}
__device__ __forceinline__ void ph3_mixers(const Params& P, Frame& F, char* lds_gen, const int reps) {
    unsigned char* ws = P.ws;
    SWR_BEGIN(31); p3_pooldiff(P, F); SWR_END(31);
    SWR_BEGIN(32);
    const float lam = __expf(wave_sum(P.lq1[F.lane] * P.lk1[F.lane])) - __expf(wave_sum(P.lq2[F.lane] * P.lk2[F.lane])) + 0.2f;
    att::Weave wv{P.w_gate, P.w_up, P.w_down, ws + WS_WGU, ws + WS_WD, 0, 0, -1};
    { const int per = (6144 + F.G - 1) / F.G; wv.next = F.vcu * per; wv.end = wv.next + per < 6144 ? wv.next + per : 6144; if (wv.next > 6144) wv.next = 6144; }
    const int rounds = (NB * 4 * 16 + F.G - 1) / F.G;
    for (int ii = 0; ii < reps * rounds; ++ii) {
        const int i = ii % rounds;
        const int U = i * F.G + F.vcu; if (U >= NB * 4 * 16) continue;
        const int bh = U >> 4, qb = U & 15;
        att::attn_unit((const bf16_t*)(ws + WS_Q), (const bf16_t*)(ws + WS_K), (const bf16_t*)(ws + WS_V), (bf16_t*)(ws + WS_MIXIN), bh >> 2, bh & 3, qb, lam, P.subln_g, lds_gen, F.lds, wv);
    }
    SWR_END(32);
    SWR_BEGIN(33);
    while (wv.pend >= 0 || wv.next < wv.end) { asm volatile("s_waitcnt vmcnt(0)" ::: "memory"); att::weave_step(wv, lds_gen, F.lds, F.wave, F.lane); }
    SWR_END(33);
}
__device__ __forceinline__ void ph4_outproj(const Params& P, Frame& F) {
    unsigned char* ws = P.ws;
    gm::DenseOrder S; S.init(ws + WS_MIXIN, ws + WS_WMIX, NTOK, DM, DM, F.G, (int)blockIdx.x);
    gm::EpiMix E{(bf16_t*)(ws + WS_X1), (const float*)(ws + WS_MODF) + 2 * 1024, P.x};
    gm::gemm_phase<gm::EpiMix, gm::DenseOrder>(F.lds, S, E);
}
__device__ __forceinline__ void ph6_gateup(const Params& P, Frame& F, gm::MoeOrder S) {
    unsigned char* ws = P.ws;
    S.KB = DM; S.A = (const char*)(ws + WS_H2); S.Bt = (const char*)(ws + WS_WGU); S.bexp = (size_t)DM * DM; S.gather = true;
    gm::EpiGateUp E{ws + WS_HID};
    gm::gemm_phase<gm::EpiGateUp, gm::MoeOrder, true>(F.lds, S, E);
}
__device__ __forceinline__ void ph7_down(const Params& P, Frame& F, gm::MoeOrder S) {
    unsigned char* ws = P.ws;
    S.KB = DEXP; S.A = (const char*)(ws + WS_HID); S.Bt = (const char*)(ws + WS_WD); S.bexp = (size_t)DM * DEXP; S.gather = false;
    gm::EpiDown E{ws + WS_YS, (const LAS int*)(F.lds + TB_TOK), (const LAS float*)(F.lds + TB_W)};
    gm::gemm_phase<gm::EpiDown, gm::MoeOrder, true>(F.lds, S, E);
}

__global__ void __launch_bounds__(NTHR, 2) fwd_kernel(Params P) {
    extern __shared__ __attribute__((aligned(16))) unsigned char lds_raw[];
    Frame F;
    F.lds = (LAS unsigned char*)lds_raw;
    F.tid = threadIdx.x; F.lane = F.tid & 63; F.wave = __builtin_amdgcn_readfirstlane(F.tid >> 6);
    F.G = gridDim.x; { const int bx = blockIdx.x; F.vcu = (F.G % 8 == 0) ? (bx % 8) * (F.G / 8) + bx / 8 : bx; }
    unsigned char* ws = P.ws;
    gu32* ctl = (gu32*)(ws + WS_CTL);
    volatile LAS unsigned* MISC = (volatile LAS unsigned*)(F.lds + MISC_OFF);
    for (int u = F.tid; u < (LDS_BYTES - RING_BYTES) / 4; u += NTHR) ((LAS unsigned*)(F.lds + RING_BYTES))[u] = 0u;
    __syncthreads();
    const int lo = (int)(P.ph & 0xff), hi = (int)((P.ph >> 8) & 0xff), li = (int)((P.ph >> 16) & 0xff);
    XcdBarrier bar; bar.bar = (unsigned*)(ctl + CW_BAR) + li * XCD_BAR_WORDS; bar.x = 0; bar.st = nullptr;
    if (N_LAUNCHES != N_PHASES) bar = xcd_barrier_post((unsigned*)(ctl + CW_BAR) + li * XCD_BAR_WORDS, MISC + 8);
#define IN(k) (lo <= (k) && (k) < hi)
#define GRID_BAR(k) do { if (IN(k) && IN((k) + 1)) xcd_barrier(bar); } while (0)
#define RUN(k, call) do { if (IN(k)) { { constexpr int rep = 0; (void)rep; call; } if (PROBE_PHASE == (k)) { xcd_barrier(bar); { constexpr int rep = 1; (void)rep; call; } } GRID_BAR(k); } } while (0)

    RUN(0, p0_prologue(P, F));
    RUN(1, p1_norm1(P, F));
    RUN(2, ph2_inproj(P, F));
    if (IN(3)) { ph3_mixers(P, F, (char*)lds_raw, PROBE_PHASE == 3 ? 2 : 1); GRID_BAR(3); }
    RUN(4, ph4_outproj(P, F));
    if (IN(5)) { p5_norm2_route(P, F, PROBE_PHASE == 5 ? 2 : 1); GRID_BAR(5); }
    if (IN(6) || IN(7)) {
        const int nrt = p6_tables(P, F);
        gm::MoeOrder S; S.rt_e = (const LAS int*)(F.lds + TB_RTE); S.rtbase = (const LAS int*)(F.lds + TB_RTB); S.tokrow = (const LAS int*)(F.lds + TB_TOK);
        S.nunits = 4 * nrt; S.G = F.G; S.c = (int)blockIdx.x; S.KB = 0; S.A = nullptr; S.Bt = nullptr; S.bexp = 0; S.gather = false;
        p6_rowlists(P, F, S);
        RUN(6, ph6_gateup(P, F, S));
        RUN(7, ph7_down(P, F, S));
    }
    RUN(8, p8_final(P, F, (rep == 0 && PROBE_PHASE == 8) ? (float*)(ws + WS_A) : P.out));
#undef IN
#undef GRID_BAR
#undef RUN
}

extern "C" void kernel_launch(void* const* d_in, const int* in_sizes, int n_in, void* d_out, int out_size, void* d_ws, size_t ws_size, hipStream_t stream) {
    static int grid = 0;
    if (grid == 0) {
        if (n_in != 23 || in_sizes[0] != NTOK * DM || out_size != NTOK * DM || ws_size < WS_END) { fprintf(stderr, "kernel_launch: unexpected shapes (n_in %d, in0 %d, out %d, ws %zu)\n", n_in, n_in > 0 ? in_sizes[0] : -1, out_size, ws_size); grid = -1; return; }
        int dev = 0, cus = 0, per_cu = 0;
        if (hipGetDevice(&dev) != hipSuccess || hipDeviceGetAttribute(&cus, hipDeviceAttributeMultiprocessorCount, dev) != hipSuccess) { grid = -1; return; }
        if (hipFuncSetAttribute((const void*)fwd_kernel, hipFuncAttributeMaxDynamicSharedMemorySize, LDS_BYTES) != hipSuccess) { fprintf(stderr, "kernel_launch: hipFuncSetAttribute failed\n"); grid = -1; return; }
        if (hipOccupancyMaxActiveBlocksPerMultiprocessor(&per_cu, (const void*)fwd_kernel, NTHR, LDS_BYTES) != hipSuccess || per_cu < 1) fprintf(stderr, "kernel_launch: occupancy query reports %d\n", per_cu);
        (void)hipGetLastError();
        grid = cus;
    }
    if (grid < 0) return;
    if (hipMemsetAsync((char*)d_ws + WS_CTL, 0, CTL_ZERO_BYTES, stream) != hipSuccess) return;
    Params p{};
    const float** pp = (const float**)&p;
    for (int i = 0; i < 23; ++i) pp[i] = (const float*)d_in[i];
    p.out = (float*)d_out; p.ws = (unsigned char*)d_ws;
    if (N_LAUNCHES == 1) { p.ph = 0 | ((long long)N_PHASES << 8); hipLaunchKernelGGL(fwd_kernel, dim3(grid), dim3(NTHR), LDS_BYTES, stream, p); }
    else for (int k = 0; k < N_PHASES; ++k) {
        p.ph = (long long)k | ((long long)(k + 1) << 8); hipLaunchKernelGGL(fwd_kernel, dim3(grid), dim3(NTHR), LDS_BYTES, stream, p); }
}
```
